# Optimizing an MI355X kernel written in HIP

```python
import jax, jax.numpy as jnp
from jax import lax
import numpy as np

D_MODEL = 4096
BATCH = 2
SEQ = 8192
DEPTH = 2

N_MIXERS = 2
N_POOL_LAYERS = (DEPTH + 1) // 2
N_ATTN_LAYERS = DEPTH // 2
SELF_W = 3 * D_MODEL // 4
MEM_LEN = 256
XA_HEADS = 4
XA_W = D_MODEL // 4
XA_HEAD_DIM = XA_W // XA_HEADS
POOL_WINDOWS = (2, 4, 8, 16)
N_POOL_GROUPS = len(POOL_WINDOWS)
POOL_GROUP = SELF_W // N_POOL_GROUPS
HEAD_DIM = 128
N_Q_HEADS = SELF_W // HEAD_DIM
GQA_GROUP = 8
N_KV_HEADS = N_Q_HEADS // GQA_GROUP
KV_W = N_KV_HEADS * HEAD_DIM
WINDOW = 128
BLOCK = WINDOW
ROT_DIM = HEAD_DIM // 4
ROPE_THETA = 500000.0
D_FF = 4 * D_MODEL
EPS = 1e-6
NEG = -1e30

kernel_name = "hybrid_pool_swa_memxattn_sqrelu"


def rms_norm(x, g):
    xf = x.astype(jnp.float32)
    y = xf * lax.rsqrt(jnp.mean(xf * xf, axis=-1, keepdims=True) + EPS)
    return (y * g.astype(jnp.float32)).astype(x.dtype)


def rope_tables(positions):
    inv_freq = ROPE_THETA ** (-jnp.arange(0, ROT_DIM, 2, dtype=jnp.float32) / ROT_DIM)
    ang = positions.astype(jnp.float32)[..., None] * inv_freq
    return jnp.cos(ang)[:, :, None, :], jnp.sin(ang)[:, :, None, :]


def partial_rope(x, cos, sin):
    xf = x.astype(jnp.float32)
    x1 = xf[..., : ROT_DIM // 2]
    x2 = xf[..., ROT_DIM // 2: ROT_DIM]
    rot = jnp.concatenate([x1 * cos - x2 * sin, x2 * cos + x1 * sin], axis=-1)
    return jnp.concatenate([rot, xf[..., ROT_DIM:]], axis=-1).astype(x.dtype)


def causal_pool_mixer(u, w_group, scale):
    B, S, _ = u.shape
    ug = u.reshape(B, S, N_POOL_GROUPS, POOL_GROUP)
    c0 = jnp.pad(jnp.cumsum(ug.astype(jnp.float32), axis=1), ((0, 0), (1, 0), (0, 0), (0, 0)))
    t1 = jnp.arange(1, S + 1, dtype=jnp.float32)
    means = []
    for g, w in enumerate(POOL_WINDOWS):
        cg = c0[:, :, g]
        lo = jnp.concatenate([jnp.zeros_like(cg[:, : w - 1]), cg[:, : S + 1 - w]], axis=1)
        means.append((cg[:, 1:] - lo) / jnp.minimum(t1, float(w))[None, :, None])
    pooled = jnp.stack(means, axis=2)
    p = (pooled - ug.astype(jnp.float32)).astype(u.dtype)
    y = jnp.einsum('bsgc,gcd->bsgd', p, w_group)
    return y.reshape(B, S, SELF_W) * scale


def sliding_window_gqa_sinks(q, k, v, sink):
    B, S = q.shape[:2]
    nb = S // BLOCK
    qb = q.reshape(B, nb, BLOCK, N_KV_HEADS, GQA_GROUP, HEAD_DIM)
    kb = k.reshape(B, nb, BLOCK, N_KV_HEADS, HEAD_DIM)
    vb = v.reshape(B, nb, BLOCK, N_KV_HEADS, HEAD_DIM)

    def with_prev(t):
        prev = jnp.pad(t[:, :-1], ((0, 0), (1, 0), (0, 0), (0, 0), (0, 0)))
        return jnp.concatenate([prev, t], axis=2)

    kc, vc = with_prev(kb), with_prev(vb)
    s = jnp.einsum('bnqhgd,bnkhd->bnhgqk', qb, kc).astype(jnp.float32) * (HEAD_DIM ** -0.5)
    qi = jnp.arange(BLOCK)[:, None]
    kj = jnp.arange(2 * BLOCK)[None, :]
    rel = qi + BLOCK - kj
    band = (rel >= 0) & (rel < WINDOW)
    valid = (jnp.arange(nb)[:, None, None] > 0) | (kj >= BLOCK)[None]
    mask = band[None] & valid
    s = jnp.where(mask[None, :, None, None], s, NEG)
    sink_b = jnp.broadcast_to(
        sink.astype(jnp.float32).reshape(N_KV_HEADS, GQA_GROUP)[None, None, :, :, None, None],
        s.shape[:-1] + (1,))
    p = jax.nn.softmax(jnp.concatenate([s, sink_b], axis=-1), axis=-1)[..., :-1]
    o = jnp.einsum('bnhgqk,bnkhd->bnqhgd', p.astype(v.dtype), vc)
    return o.reshape(B, S, N_Q_HEADS * HEAD_DIM)


def memory_cross_attention(xq, mem_kv):
    B, S, _ = xq.shape
    M = mem_kv.shape[1]
    q = xq.reshape(B, S, XA_HEADS, XA_HEAD_DIM)
    k = mem_kv[..., :XA_W].reshape(B, M, XA_HEADS, XA_HEAD_DIM)
    v = mem_kv[..., XA_W:].reshape(B, M, XA_HEADS, XA_HEAD_DIM)
    s = jnp.einsum('bshd,bmhd->bhsm', q, k).astype(jnp.float32) * (XA_HEAD_DIM ** -0.5)
    p = jax.nn.softmax(s, axis=-1)
    return jnp.einsum('bhsm,bmhd->bshd', p.astype(v.dtype), v).reshape(B, S, XA_W)


def setup_inputs(seed: int = 0) -> dict:
    key = jax.random.key(seed)
    ks = jax.random.split(key, 20)
    f32 = jnp.float32

    def nrm(k, shape, fan_in):
        return jax.random.normal(k, shape, f32) * (fan_in ** -0.5)

    def gain(k, shape):
        return 1.0 + 0.05 * jax.random.normal(k, shape, f32)

    x = jax.random.normal(ks[0], (BATCH, SEQ, D_MODEL), f32)
    mem = jax.random.normal(ks[1], (BATCH, MEM_LEN, D_MODEL), f32)
    offset = jax.random.randint(ks[2], (BATCH, 1), 0, 4096, dtype=jnp.int32)
    positions = offset + jnp.arange(SEQ, dtype=jnp.int32)[None, :]
    return {
        "x": x,
        "mem": mem,
        "positions": positions,
        "norm_mix": gain(ks[3], (DEPTH, D_MODEL)),
        "norm_mem": gain(ks[4], (DEPTH, D_MODEL)),
        "norm_mlp": gain(ks[5], (DEPTH, D_MODEL)),
        "w_mem_kv": nrm(ks[6], (DEPTH, D_MODEL, 2 * XA_W), D_MODEL),
        "pool_w_in": nrm(ks[7], (N_POOL_LAYERS, D_MODEL, SELF_W + XA_W), D_MODEL),
        "pool_w_group": nrm(ks[8], (N_POOL_LAYERS, N_POOL_GROUPS, POOL_GROUP, POOL_GROUP), POOL_GROUP),
        "pool_scale": 1.0 + 0.1 * jax.random.normal(ks[9], (N_POOL_LAYERS, SELF_W), f32),
        "pool_w_out": nrm(ks[10], (N_POOL_LAYERS, SELF_W + XA_W, D_MODEL), SELF_W + XA_W),
        "attn_w_in": nrm(ks[11], (N_ATTN_LAYERS, D_MODEL, SELF_W + 2 * KV_W + XA_W), D_MODEL),
        "attn_sink": 0.5 * jax.random.normal(ks[12], (N_ATTN_LAYERS, N_Q_HEADS), f32),
        "attn_w_out": nrm(ks[13], (N_ATTN_LAYERS, SELF_W + XA_W, D_MODEL), SELF_W + XA_W),
        "mlp_w1": nrm(ks[14], (DEPTH, D_MODEL, D_FF), D_MODEL),
        "mlp_w2": nrm(ks[15], (DEPTH, D_FF, D_MODEL), D_FF),
        "final_norm": gain(ks[16], (D_MODEL,)),
    }


def reference(x, mem, positions, norm_mix, norm_mem, norm_mlp, w_mem_kv,
              pool_w_in, pool_w_group, pool_scale, pool_w_out,
              attn_w_in, attn_sink, attn_w_out, mlp_w1, mlp_w2, final_norm):
    B, S, _ = x.shape
    cos, sin = rope_tables(positions)
    h = x
    for i in range(DEPTH):
        j = i // N_MIXERS
        hn = rms_norm(h, norm_mix[i])
        mem_kv = rms_norm(mem, norm_mem[i]) @ w_mem_kv[i]
        if i % N_MIXERS == 0:
            proj = hn @ pool_w_in[j]
            y_self = causal_pool_mixer(proj[..., :SELF_W], pool_w_group[j], pool_scale[j])
            xq = proj[..., SELF_W:]
            w_out = pool_w_out[j]
        else:
            proj = hn @ attn_w_in[j]
            q = proj[..., :SELF_W].reshape(B, S, N_Q_HEADS, HEAD_DIM)
            k = proj[..., SELF_W:SELF_W + KV_W].reshape(B, S, N_KV_HEADS, HEAD_DIM)
            v = proj[..., SELF_W + KV_W:SELF_W + 2 * KV_W].reshape(B, S, N_KV_HEADS, HEAD_DIM)
            xq = proj[..., SELF_W + 2 * KV_W:]
            q = partial_rope(q, cos, sin)
            k = partial_rope(k, cos, sin)
            y_self = sliding_window_gqa_sinks(q, k, v, attn_sink[j])
            w_out = attn_w_out[j]
        y_mem = memory_cross_attention(xq, mem_kv)
        h = h + jnp.concatenate([y_self, y_mem], axis=-1) @ w_out
        hn = rms_norm(h, norm_mlp[i])
        h = h + jnp.square(jax.nn.relu(hn @ mlp_w1[i])) @ mlp_w2[i]
    return rms_norm(h, final_norm)
```

```cpp
#include <hip/hip_runtime.h>
#include <cstdio>
#include <cstdint>

#define SWZ_XOR(v, k) __builtin_bit_cast(float, __builtin_amdgcn_ds_swizzle(__builtin_bit_cast(int, (float)(v)), (((k) << 10) | 0x1f)))
__device__ __forceinline__ float xor16_add(float v) { return v + SWZ_XOR(v, 16); }
__device__ __forceinline__ float xor16_max(float v) { return fmaxf(v, SWZ_XOR(v, 16)); }
__device__ __forceinline__ float xor32_add(float v) { auto r = __builtin_amdgcn_permlane32_swap(__float_as_uint(v), __float_as_uint(v), false, false); const unsigned a = r[0], b = r[1]; return __uint_as_float(a) + __uint_as_float(b); }
__device__ __forceinline__ float xor32_max(float v) { auto r = __builtin_amdgcn_permlane32_swap(__float_as_uint(v), __float_as_uint(v), false, false); const unsigned a = r[0], b = r[1]; return fmaxf(__uint_as_float(a), __uint_as_float(b)); }
__device__ __forceinline__ float xor32_other(float v, bool lo_half) { auto r = __builtin_amdgcn_permlane32_swap(__float_as_uint(v), __float_as_uint(v), false, false); const unsigned a = r[0], b = r[1]; return __uint_as_float(lo_half ? b : a); }
__device__ __forceinline__ float dpp_xor1(float v) { return __builtin_bit_cast(float, __builtin_amdgcn_mov_dpp(__builtin_bit_cast(int, v), 0xB1, 0xF, 0xF, true)); }

namespace pg8 {
#define PG8_LAS __attribute__((address_space(3)))
typedef unsigned short bf16_t;
typedef short bf16x8 __attribute__((ext_vector_type(8)));
typedef float f32x4 __attribute__((ext_vector_type(4)));
typedef unsigned u32x4 __attribute__((ext_vector_type(4)));
typedef unsigned u32x2 __attribute__((ext_vector_type(2)));
constexpr int BM = 256, BK = 64, HALF = 128, HTB = HALF * BK * 2  , STAGE_BYTES = 8 * HTB, NXCD = 8, WGM = 8;

__host__ __device__ __forceinline__ int lds_byte(int r, int c) { const int st = (r >> 4) * 2 + (c >> 5), rr = r & 15, cc = c & 31, ob = rr * 64 + cc * 2; return st * 1024 + (ob ^ (((ob >> 9) & 1) << 5)); }
__host__ __device__ __forceinline__ void stage_rc(int b, int& R, int& C) { const int st = b / 1024, sb = b % 1024, swz = sb ^ (((sb >> 9) & 1) << 5); R = (st >> 1) * 16 + swz / 64; C = (st & 1) * 32 + (swz % 64) / 2; }
__host__ __device__ __forceinline__ int perm32(int rho) { const int n = rho >> 4, i = rho & 15; return 8 * (i >> 2) + 4 * n + (i & 3); }

struct Unit { int pm, pn, z; const char* a; const char* b; };

struct GridOrder {
    int nM, nN, nwg, G, c; const char* A; const char* B; size_t ta, tb;
    __device__ __forceinline__ void init(int M, int N, int G_, int c_, const void* A_, size_t lda, const void* B_, size_t ldb) { nM = M / BM; nN = N / BM; nwg = nM * nN; G = G_; c = c_; A = (const char*)A_; B = (const char*)B_; ta = lda * BM; tb = ldb * BM; }
    __device__ __forceinline__ bool next(int i, Unit& u) const {
        const long L = (long)i * G + c; if (L >= nwg) return false;
        int wgid = (int)L; { const int q = nwg / NXCD, r = nwg % NXCD, xcd = wgid % NXCD, off = wgid / NXCD; wgid = (xcd < r ? xcd * (q + 1) : r * (q + 1) + (xcd - r) * q) + off; }
        const int nig = WGM * nN, gid = wgid / nig, fm = gid * WGM, gsz = (nM - fm) < WGM ? (nM - fm) : WGM;
        u.pm = fm + ((wgid % nig) % gsz); u.pn = (wgid % nig) / gsz; u.z = 0; u.a = A + (size_t)u.pm * ta; u.b = B + (size_t)u.pn * tb; return true;
    }
};

__device__ __forceinline__ unsigned cvt_pk_bf16(float lo, float hi) { unsigned r; asm volatile("v_cvt_pk_bf16_f32 %0, %1, %2" : "=v"(r) : "v"(lo), "v"(hi)); return r; }
__device__ __forceinline__ void st_bf16x8(bf16_t* p, f32x4 v0, f32x4 v1) { u32x4 w; w.x = cvt_pk_bf16(v0[0], v0[1]); w.y = cvt_pk_bf16(v0[2], v0[3]); w.z = cvt_pk_bf16(v1[0], v1[1]); w.w = cvt_pk_bf16(v1[2], v1[3]); *(u32x4*)p = w; }


template <class Epi, class Sched>
__device__ __forceinline__ void gemm_phase(PG8_LAS unsigned char* lds, const int tid  , const unsigned lda, const unsigned ldb, const int nt, const Sched& S, const Epi& E) {
    constexpr bool ALIGN_EPI = true;
    const int wid = __builtin_amdgcn_readfirstlane(tid >> 6), lane = tid & 63, wr = wid >> 2, wc = wid & 3, fr = lane & 15, fq = lane >> 4;
    unsigned voffA[2], voffB[2];
#pragma unroll
    for (int i = 0; i < 2; ++i) { int R, C; stage_rc(tid * 16 + i * 8192, R, C); const int Rb = (R & ~31) + perm32(R & 31);
        voffA[i] = (unsigned)R * lda + (unsigned)C * 2u; voffB[i] = (unsigned)Rb * ldb + (unsigned)C * 2u; }
    const size_t kstep = (size_t)(BK * 2);
    const size_t hstepA = (size_t)HALF * lda, hstepB = (size_t)HALF * ldb;
    const unsigned ldsw = (unsigned)wid * 1024u;
    const int aoff = lds_byte(wr * 64 + fr, fq * 8), boff = lds_byte(wc * 32 + fr, fq * 8);
#define PG8_SA(b, h) (((b) * 2 + (h)) * HTB)
#define PG8_SB(b, h) ((4 + (b) * 2 + (h)) * HTB)
#define PG8_STAGE(bufoff, gbase, voff) do { _Pragma("unroll") for (int _i = 0; _i < 2; ++_i) \
        __builtin_amdgcn_global_load_lds((const unsigned*)((const char*)(gbase) + (voff)[_i]), (PG8_LAS unsigned*)(lds + (bufoff) + ldsw + _i * 8192), 16, 0, 0); } while (0)
#define PG8_LDA(dst, b, h) do { _Pragma("unroll") for (int m = 0; m < 4; ++m) _Pragma("unroll") for (int k = 0; k < 2; ++k) dst[m][k] = *(const PG8_LAS bf16x8*)(lds + PG8_SA(b, h) + aoff + m * 2048 + k * 1024); } while (0)
#define PG8_LDB(dst, b, h) do { _Pragma("unroll") for (int n = 0; n < 2; ++n) _Pragma("unroll") for (int k = 0; k < 2; ++k) dst[n][k] = *(const PG8_LAS bf16x8*)(lds + PG8_SB(b, h) + boff + n * 2048 + k * 1024); } while (0)
#define PG8_MMA(ai, bj, At, Bt) do { __builtin_amdgcn_s_setprio(1); _Pragma("unroll") for (int m = 0; m < 4; ++m) _Pragma("unroll") for (int n = 0; n < 2; ++n) _Pragma("unroll") for (int k = 0; k < 2; ++k) \
        acc[ai][bj][m][n] = __builtin_amdgcn_mfma_f32_16x16x32_bf16(Bt[n][k], At[m][k], acc[ai][bj][m][n], 0, 0, 0); __builtin_amdgcn_s_setprio(0); } while (0)
#define PG8_WAIT_V(n) asm volatile("s_waitcnt vmcnt(" #n ")" ::: "memory")
#define PG8_WAIT_L(n) asm volatile("s_waitcnt lgkmcnt(" #n ")" ::: "memory")
#define PG8_BAR __builtin_amdgcn_s_barrier()
#define PG8_SCHED __builtin_amdgcn_sched_barrier(0)
    Unit cur, nxt; int ui = 0;
    if (!S.next(0, cur)) return;
    f32x4 acc[2][2][4][2];
#pragma unroll
    for (int a = 0; a < 2; ++a)
#pragma unroll
        for (int b = 0; b < 2; ++b)
#pragma unroll
            for (int m = 0; m < 4; ++m)
#pragma unroll
                for (int n = 0; n < 2; ++n) acc[a][b][m][n] = (f32x4){0.f, 0.f, 0.f, 0.f};
    bf16x8 At[4][2], B0[2][2], B1[2][2];
    const char* cA = cur.a; const char* cB = cur.b;
    PG8_STAGE(PG8_SB(0, 0), cB, voffB); PG8_STAGE(PG8_SB(0, 1), cB + hstepB, voffB); PG8_STAGE(PG8_SA(0, 0), cA, voffA); PG8_STAGE(PG8_SA(0, 1), cA + hstepA, voffA);
    if (wr == 1) PG8_BAR;
    PG8_WAIT_V(2); PG8_BAR;
    PG8_STAGE(PG8_SB(1, 0), cB + kstep, voffB); PG8_STAGE(PG8_SA(1, 0), cA + kstep, voffA); PG8_STAGE(PG8_SB(1, 1), cB + hstepB + kstep, voffB);
    PG8_WAIT_V(6); PG8_BAR;
    for (;;) {
        const bool has_next = S.next(ui + 1, nxt);
        const char* nA = has_next ? nxt.a : cA; const char* nB = has_next ? nxt.b : cB;
        for (int t = 0; t < nt; t += 2) {
            const bool last = (t == nt - 2);
            const char* a1 = cA + (size_t)(t + 1) * kstep;
            const char* a2 = last ? nA : cA + (size_t)(t + 2) * kstep; const char* b2 = last ? nB : cB + (size_t)(t + 2) * kstep;
            const char* a3 = a2 + kstep; const char* b3 = b2 + kstep;
            PG8_LDB(B0, 0, 0); PG8_LDB(B1, 0, 1); PG8_SCHED; PG8_LDA(At, 0, 0); PG8_STAGE(PG8_SA(1, 1), a1 + hstepA, voffA);
            PG8_WAIT_V(8); PG8_WAIT_L(0); PG8_BAR; PG8_MMA(0, 0, At, B0); PG8_MMA(0, 1, At, B1); PG8_BAR; PG8_SCHED;
            PG8_LDA(At, 0, 1); PG8_STAGE(PG8_SB(0, 0), b2, voffB); PG8_STAGE(PG8_SB(0, 1), b2 + hstepB, voffB); PG8_STAGE(PG8_SA(0, 0), a2, voffA);
            PG8_WAIT_V(8); PG8_WAIT_L(0); PG8_BAR; PG8_MMA(1, 0, At, B0); PG8_MMA(1, 1, At, B1); PG8_BAR; PG8_SCHED;
            PG8_LDB(B0, 1, 0); PG8_LDB(B1, 1, 1); PG8_SCHED; PG8_LDA(At, 1, 0); PG8_STAGE(PG8_SA(0, 1), a2 + hstepA, voffA);
            PG8_WAIT_V(8); PG8_WAIT_L(0); PG8_BAR; PG8_MMA(0, 0, At, B0); PG8_MMA(0, 1, At, B1); PG8_BAR; PG8_SCHED;
            PG8_LDA(At, 1, 1); PG8_STAGE(PG8_SB(1, 0), b3, voffB); PG8_STAGE(PG8_SB(1, 1), b3 + hstepB, voffB); PG8_STAGE(PG8_SA(1, 0), a3, voffA);
            PG8_WAIT_V(8); PG8_WAIT_L(0); PG8_BAR; PG8_MMA(1, 0, At, B0); PG8_MMA(1, 1, At, B1); PG8_BAR; PG8_SCHED;
        }
        if constexpr (ALIGN_EPI) { if (wr == 0) PG8_BAR; }
        if constexpr (!Epi::AFTER_DRAIN) {
            int l2; asm volatile("v_mbcnt_lo_u32_b32 %0, -1, 0\n\tv_mbcnt_hi_u32_b32 %0, -1, %0" : "=v"(l2));
            E(acc, cur, wr, wc, l2 & 15, l2 >> 4); }
        if (!has_next) break;
#pragma unroll
        for (int a = 0; a < 2; ++a)
#pragma unroll
            for (int b = 0; b < 2; ++b)
#pragma unroll
                for (int m = 0; m < 4; ++m)
#pragma unroll
                    for (int n = 0; n < 2; ++n) acc[a][b][m][n] = (f32x4){0.f, 0.f, 0.f, 0.f};
        cur = nxt; cA = nA; cB = nB; ++ui;
        if constexpr (ALIGN_EPI) { if (wr == 1) PG8_BAR; }
    }
    PG8_WAIT_V(0);
    if constexpr (!ALIGN_EPI) { if (wr == 0) PG8_BAR; }
    PG8_BAR;
    if constexpr (Epi::AFTER_DRAIN) { int l2; asm volatile("v_mbcnt_lo_u32_b32 %0, -1, 0\n\tv_mbcnt_hi_u32_b32 %0, -1, %0" : "=v"(l2)); E.fused(acc, cur, wr, wc, l2 & 15, l2 >> 4, lds, wid, l2); }
#undef PG8_SA
#undef PG8_SB
#undef PG8_STAGE
#undef PG8_LDA
#undef PG8_LDB
#undef PG8_MMA
#undef PG8_WAIT_V
#undef PG8_WAIT_L
#undef PG8_BAR
#undef PG8_SCHED
}
}

namespace swa {
typedef unsigned short bf16;
typedef short bf16x8 __attribute__((ext_vector_type(8)));
typedef short s16x4 __attribute__((ext_vector_type(4)));
typedef float f32x16 __attribute__((ext_vector_type(16)));
typedef float f32x4 __attribute__((ext_vector_type(4)));
typedef unsigned u32x4 __attribute__((ext_vector_type(4)));
template <class A, class Bt> struct same_t { static constexpr bool v = false; };
template <class A> struct same_t<A, A> { static constexpr bool v = true; };
constexpr int D = 128;
constexpr int QP = 4864, OP = 4096;
constexpr int WINDOW = 128; constexpr float THR = 8.f; constexpr bool WSKIP = false;
constexpr float SCALE = 0.08838834764831845f;
constexpr int NW = 8, QBLK = 32, KVBLK = 64, QB = NW * QBLK;
constexpr int SHM_V = KVBLK * D * 2, SHM_K = KVBLK * D * 2;
constexpr int LDS_BYTES = 2 * SHM_V + 2 * SHM_K + NW * 64 * 4;
#define KSWZ(row, colB) ((row) * 256 + ((colB) ^ (((row) & 7) << 4)))
#define SBAR() __builtin_amdgcn_sched_barrier(0)
__device__ __forceinline__ int v_st(int k, int c) { const int kk = (k & ~0xC) | ((k & 4) << 1) | ((k & 8) >> 1); return ((kk >> 3) * 4 + (c >> 5)) * 512 + ((kk & 7) * 32 + (c & 31)) * 2; }
__device__ __forceinline__ int v_rd_base(int lane) { return ((lane & 3) << 3) | (((lane >> 2) & 3) << 6) | (((lane >> 4) & 1) << 5) | (((lane >> 5) & 1) << 8); }
constexpr int v_rd_off(int d0, int ks, int half) { return d0 * 512 + ks * 4096 + half * 2048; }
__device__ __forceinline__ int crow(int r, int hi) { return (r & 3) + 8 * (r >> 2) + 4 * hi; }
__device__ __forceinline__ unsigned cvtpk(float lo, float hi) {
    unsigned r; asm volatile("v_cvt_pk_bf16_f32 %0, %1, %2" : "=v"(r) : "v"(lo), "v"(hi)); return r;
}
__device__ __forceinline__ bf16x8 pack8(f32x4 a, f32x4 b) {
    u32x4 w = {cvtpk(a[0], a[1]), cvtpk(a[2], a[3]), cvtpk(b[0], b[1]), cvtpk(b[2], b[3])};
    return *reinterpret_cast<bf16x8*>(&w);
}
template <class T> __device__ __forceinline__ bf16x8 load8(const T* p) {
    if constexpr (same_t<T, float>::v) { return pack8(*(const f32x4*)p, *(const f32x4*)(p + 4)); }
    else { return *reinterpret_cast<const bf16x8*>(p); }
}
__device__ __forceinline__ void mask_tile(f32x16& p0, f32x16& p1, int dq, unsigned W) {
    const float NEG = -__builtin_inff();
#pragma unroll
    for (int r = 0; r < 16; ++r) {
        const int c = (r & 3) + 8 * (r >> 2);
        if ((unsigned)(dq - c) >= W) p0[r] = NEG;
        if ((unsigned)(dq - c - 32) >= W) p1[r] = NEG;
    }
}
__device__ __forceinline__ void partialSM(f32x16& p0, f32x16& p1, float& m_reg, float& mn, float& alpha) {
    float pmax = p0[0]; for (int r = 1; r < 16; ++r) pmax = fmaxf(pmax, p0[r]); for (int r = 0; r < 16; ++r) pmax = fmaxf(pmax, p1[r]);
    { auto rr = __builtin_amdgcn_permlane32_swap(__float_as_uint(pmax), __float_as_uint(pmax), false, false);
      pmax = fmaxf(__uint_as_float(rr[0]), __uint_as_float(rr[1])); }
    constexpr float C2 = 1.4426950408889634f * SCALE;
    if (__builtin_expect(__all((pmax - m_reg) * SCALE <= THR), 1)) { mn = m_reg; alpha = 1.f; }
    else { mn = fmaxf(m_reg, pmax); alpha = __builtin_amdgcn_exp2f((m_reg - mn) * C2); m_reg = mn; }
    const float mnL = -mn * C2;
    for (int r = 0; r < 16; ++r) p0[r] = fmaf(p0[r], C2, mnL); for (int r = 0; r < 16; ++r) p1[r] = fmaf(p1[r], C2, mnL);
    for (int r = 0; r < 16; ++r) p0[r] = __builtin_amdgcn_exp2f(p0[r]);
}
__device__ __forceinline__ void finishSM(f32x16& p0, f32x16& p1, float alpha, float& l_reg, bf16x8& pa0, bf16x8& pa1, bf16x8& pa2, bf16x8& pa3) {
    for (int r = 0; r < 16; ++r) p1[r] = __builtin_amdgcn_exp2f(p1[r]);
    float ps = 0; for (int r = 0; r < 16; ++r) ps += p0[r]; for (int r = 0; r < 16; ++r) ps += p1[r];
    { auto rr = __builtin_amdgcn_permlane32_swap(__float_as_uint(ps), __float_as_uint(ps), false, false);
      ps = __uint_as_float(rr[0]) + __uint_as_float(rr[1]); }
    l_reg = l_reg * alpha + ps;
#define PK4(P, B_, OUT) do { unsigned a0 = cvtpk(P[B_+0], P[B_+1]), a1 = cvtpk(P[B_+2], P[B_+3]);                          \
        unsigned b0 = cvtpk(P[B_+4], P[B_+5]), b1 = cvtpk(P[B_+6], P[B_+7]);                                             \
        auto r0 = __builtin_amdgcn_permlane32_swap(a0, b0, false, false); auto r1 = __builtin_amdgcn_permlane32_swap(a1, b1, false, false); \
        u32x4 w = {r0[0], r1[0], r0[1], r1[1]}; OUT = *reinterpret_cast<bf16x8*>(&w); } while (0)
    PK4(p0, 0, pa0); PK4(p0, 8, pa1); PK4(p1, 0, pa2); PK4(p1, 8, pa3);
#undef PK4
}
template <int KB, bool SK>
__device__ __forceinline__ void qkt(f32x16& p0, f32x16& p1, const char* K_lds, int r32, int hi, const bf16x8* qr, bool act) {
    if (SK && !act) { const float NEG = -__builtin_inff();
#pragma unroll
        for (int r = 0; r < 16; ++r) { p0[r] = NEG; p1[r] = NEG; } return; }
    p0 = f32x16{}; p1 = f32x16{};
    const char* kb[4];
#pragma unroll
    for (int dd = 0; dd < 4; ++dd) kb[dd] = K_lds + KB * SHM_K + KSWZ(r32, (dd * 16 + hi * 8) * 2);
#pragma unroll
    for (int d0 = 0; d0 < 8; ++d0) { const char* a = kb[d0 & 3] + (d0 >> 2) * 128;
        bf16x8 b0 = *reinterpret_cast<const bf16x8*>(a);
        bf16x8 b1 = *reinterpret_cast<const bf16x8*>(a + 32 * 256);
        p0 = __builtin_amdgcn_mfma_f32_32x32x16_bf16(b0, qr[d0], p0, 0, 0, 0);
        p1 = __builtin_amdgcn_mfma_f32_32x32x16_bf16(b1, qr[d0], p1, 0, 0, 0); }
}
template <int VB, bool SK>
__device__ __forceinline__ void pv_tile(f32x16* o, int vb0, bf16x8 pa0, bf16x8 pa1, bf16x8 pa2, bf16x8 pa3, bool act) {
    if (SK && !act) return;
#define TRRD(dst, off) asm volatile("ds_read_b64_tr_b16 %0, %1 offset:%2" : "=&v"(dst) : "v"(vb0), "i"(off) : "memory")
#define PV_D0(d0) do { s16x4 l0, l1, l2, l3, h0, h1, h2, h3; constexpr int b_ = VB * SHM_V + v_rd_off(d0, 0, 0);     \
        TRRD(l0, b_); TRRD(h0, b_ + 2048); TRRD(l1, b_ + 4096); TRRD(h1, b_ + 6144); TRRD(l2, b_ + 8192); TRRD(h2, b_ + 10240); TRRD(l3, b_ + 12288); TRRD(h3, b_ + 14336); \
        asm volatile("s_waitcnt lgkmcnt(0)" ::: "memory"); SBAR();                 \
        o[d0] = __builtin_amdgcn_mfma_f32_32x32x16_bf16(pa0, (bf16x8){l0[0], l0[1], l0[2], l0[3], h0[0], h0[1], h0[2], h0[3]}, o[d0], 0, 0, 0);   \
        o[d0] = __builtin_amdgcn_mfma_f32_32x32x16_bf16(pa1, (bf16x8){l1[0], l1[1], l1[2], l1[3], h1[0], h1[1], h1[2], h1[3]}, o[d0], 0, 0, 0);   \
        o[d0] = __builtin_amdgcn_mfma_f32_32x32x16_bf16(pa2, (bf16x8){l2[0], l2[1], l2[2], l2[3], h2[0], h2[1], h2[2], h2[3]}, o[d0], 0, 0, 0);   \
        o[d0] = __builtin_amdgcn_mfma_f32_32x32x16_bf16(pa3, (bf16x8){l3[0], l3[1], l3[2], l3[3], h3[0], h3[1], h3[2], h3[3]}, o[d0], 0, 0, 0); } while (0)
    PV_D0(0); PV_D0(1); PV_D0(2); PV_D0(3);
#undef PV_D0
#undef TRRD
}

template <class TIn, class TOut> struct BlockRef { const TIn* Q; const TIn* K; const TIn* V; TOut* O; int P0; const float* sink; };
template <class TIn> struct Seam {
    bf16x8 qr[8];
    bf16x8 st_v0, st_v1, st_k0, st_k1; f32x4 sf0, sf1, sf2, sf3;
    f32x4 tq[16];
};
__device__ __forceinline__ int swa_jlo(int P0, int W) { const int lowk = P0 - W + 1; return lowk > 0 ? lowk / KVBLK : 0; }
#define ROW(p, k0, rr) ((p) + (size_t)((k0) + (rr)) * QP + sc)
#define VMW() asm volatile("s_waitcnt vmcnt(0)" ::: "memory")
#define VMWN(n) asm volatile("s_waitcnt vmcnt(%0)" :: "i"(n) : "memory")
#define SLOAD_H(Kp, Vp, k0) do { S.st_v0 = load8<TIn>(ROW(Vp, k0, sr)); S.st_v1 = load8<TIn>(ROW(Vp, k0, 32 + sr));              \
                         S.st_k0 = load8<TIn>(ROW(Kp, k0, sr)); S.st_k1 = load8<TIn>(ROW(Kp, k0, 32 + sr)); } while (0)
#define SWRITE_HK(bf) do { *(bf16x8*)(K_lds + (bf) * SHM_K + kws) = S.st_k0; *(bf16x8*)(K_lds + (bf) * SHM_K + kws + 32 * 256) = S.st_k1; } while (0)
#define SWRITE_HV(bf) do { *(bf16x8*)(V_lds + (bf) * SHM_V + vst0) = S.st_v0; *(bf16x8*)(V_lds + (bf) * SHM_V + vst1) = S.st_v1; } while (0)
#define SWRITE_H(bf) do { SWRITE_HV(bf); SWRITE_HK(bf); } while (0)
#define SLOAD_F(p, k0) do { S.sf0 = *(const f32x4*)ROW(p, k0, sr); S.sf1 = *(const f32x4*)(ROW(p, k0, sr) + 4);                \
                            S.sf2 = *(const f32x4*)ROW(p, k0, 32 + sr); S.sf3 = *(const f32x4*)(ROW(p, k0, 32 + sr) + 4); } while (0)
#define SWRITE_KF(bf) do { *(bf16x8*)(K_lds + (bf) * SHM_K + kws) = pack8(S.sf0, S.sf1); *(bf16x8*)(K_lds + (bf) * SHM_K + kws + 32 * 256) = pack8(S.sf2, S.sf3); } while (0)
#define SWRITE_VF(bf) do { *(bf16x8*)(V_lds + (bf) * SHM_V + vst0) = pack8(S.sf0, S.sf1); *(bf16x8*)(V_lds + (bf) * SHM_V + vst1) = pack8(S.sf2, S.sf3); } while (0)
template <class TIn, class TOut>
__device__ __forceinline__ void causal_swa_prime(const BlockRef<TIn, TOut>& cur, int W, char* lds, Seam<TIn>& S, const int tid) {
    constexpr bool F32 = same_t<TIn, float>::v;
    const int wid = __builtin_amdgcn_readfirstlane(tid >> 6), lane = tid & 63, r32 = lane & 31, hi = lane >> 5;
    const int sr = tid >> 4, sc = (tid & 15) * 8, kws = KSWZ(sr, sc * 2); char* K_lds = lds + 2 * SHM_V;
    const int kb0 = swa_jlo(cur.P0, W) * KVBLK;
    for (int d0 = 0; d0 < 8; ++d0) S.qr[d0] = load8<TIn>(cur.Q + (size_t)r32 * QP + wid * D + d0 * 16 + hi * 8);
    if constexpr (F32) { SLOAD_F((const float*)cur.K, kb0); VMW(); SWRITE_KF(0); SBAR(); SLOAD_F((const float*)cur.V, kb0); }
    else { SLOAD_H(cur.K, cur.V, kb0); VMW(); SWRITE_HK(0); }
    __syncthreads();
}
template <class TIn, class TOut>
__device__ __forceinline__ void causal_swa_block(const BlockRef<TIn, TOut>& cur, const BlockRef<TIn, TOut>& nxt, int skv, int W, char* lds, Seam<TIn>& S, const int tid) {
    constexpr bool F32 = same_t<TIn, float>::v;
    const int wid = __builtin_amdgcn_readfirstlane(tid >> 6), lane = tid & 63, r32 = lane & 31, hi = lane >> 5;
    const int j_lo = swa_jlo(cur.P0, W);
    int j_hi = (cur.P0 + QBLK - 1) / KVBLK + 1; if (j_hi > skv / KVBLK) j_hi = skv / KVBLK;
    const int NT = j_hi - j_lo;
    const int kbn = swa_jlo(nxt.P0, W) * KVBLK;
    const int qlo = cur.P0, qm = qlo + r32 - 4 * hi;
    char* V_lds = lds; char* K_lds = lds + 2 * SHM_V;
    float* ws = (float*)(lds + 2 * SHM_V + 2 * SHM_K) + wid * 64; float* li_l = ws, * al_l = ws + 32;
    float m_reg = cur.sink[wid] * (1.0f / SCALE), l_reg = 1.0f; f32x16 o[4] = {};
    const int sr = tid >> 4, sc = (tid & 15) * 8, vst0 = v_st(sr, sc), vst1 = v_st(32 + sr, sc), kws = KSWZ(sr, sc * 2);
    const int vb0 = (int)(uintptr_t)V_lds + v_rd_base(lane);
    const TIn* Kh = cur.K; const TIn* Vh = cur.V;
#define RESC(a) do { if (__any((a) < 1.f)) { if (hi == 0) al_l[r32] = (a); asm volatile("s_waitcnt lgkmcnt(0)" ::: "memory");              \
                     for (int d_ = 0; d_ < 4; ++d_) for (int r = 0; r < 16; ++r) o[d_][r] *= al_l[crow(r, hi)]; } } while (0)
#define KBASE(t) ((j_lo + (t)) * KVBLK)
#define ACT(t) (KBASE(t) <= qlo + QBLK - 1 && KBASE(t) + KVBLK - 1 >= qlo - W + 1)
#define MASKT(P0_, P1_, t) do { const int kb_ = KBASE(t); if ((!SK || ACT(t)) && (kb_ + KVBLK - 1 > qlo || kb_ <= qlo + QBLK - 1 - W)) mask_tile(P0_, P1_, qm - kb_, (unsigned)W); } while (0)
    constexpr int NQL = F32 ? 16 : 8;
    constexpr bool SK = WSKIP && !F32;
#define SEAM_K0() do { VMWN(NQL); if constexpr (F32) { SWRITE_KF(0); SBAR(); SLOAD_F((const float*)nxt.V, kbn); } else { SWRITE_HK(0); } SBAR(); } while (0)
    f32x16 pA0, pA1, pB0, pB1; float mnA, mnB, alA, alB; bf16x8 pa0, pa1, pa2, pa3;
    if constexpr (F32) { VMW(); SWRITE_VF(0); SBAR(); } else { SWRITE_HV(0); SBAR(); }
    if (NT > 1) { if constexpr (F32) SLOAD_F((const float*)Kh, KBASE(1)); else SLOAD_H(Kh, Vh, KBASE(1)); }
    SBAR(); qkt<0, SK>(pA0, pA1, K_lds, r32, hi, S.qr, ACT(0));
    if constexpr (F32) { if (NT > 1) { VMW(); SWRITE_KF(1); SBAR(); SLOAD_F((const float*)Vh, KBASE(1)); } }
    MASKT(pA0, pA1, 0); partialSM(pA0, pA1, m_reg, mnA, alA);
    if (NT > 1) { VMW(); if constexpr (F32) { SWRITE_VF(1); SBAR(); if (NT > 2) SLOAD_F((const float*)Kh, KBASE(2)); } else SWRITE_H(1); }
    __syncthreads();
#define HALF_STEP(PX0, PX1, mnX, alX, PY0, PY1, alY, t, KB, VB, SB) do {                                                      \
        SBAR(); qkt<KB, SK>(PX0, PX1, K_lds, r32, hi, S.qr, ACT(t));                                             \
        finishSM(PY0, PY1, alY, l_reg, pa0, pa1, pa2, pa3); SBAR();                                                           \
        if ((t) + 1 < NT) { if constexpr (F32) { VMW(); SWRITE_KF(SB); SBAR(); SLOAD_F((const float*)Vh, KBASE((t) + 1)); }  \
                            else { SLOAD_H(Kh, Vh, KBASE((t) + 1)); } SBAR(); }                                               \
        pv_tile<VB, SK>(o, vb0, pa0, pa1, pa2, pa3, ACT((t) - 1)); MASKT(PX0, PX1, (t)); partialSM(PX0, PX1, m_reg, mnX, alX);                                        \
        __syncthreads();                                                                                                      \
        if ((t) + 1 < NT) { VMW(); if constexpr (F32) { SWRITE_VF(SB); SBAR(); if ((t) + 2 < NT) SLOAD_F((const float*)Kh, KBASE((t) + 2)); } \
                            else { SWRITE_H(SB); } }                                                                          \
        RESC(alX); __syncthreads(); } while (0)
    for (int t = 1; t + 1 < NT; t += 2) {
        HALF_STEP(pB0, pB1, mnB, alB, pA0, pA1, alA, t, 1, 0, 0);
        HALF_STEP(pA0, pA1, mnA, alA, pB0, pB1, alB, t + 1, 0, 1, 1);
    }
    const bool even = (NT & 1) == 0;
    if (even) { SBAR(); qkt<1, SK>(pB0, pB1, K_lds, r32, hi, S.qr, ACT(NT - 1)); SBAR(); }
#define QROW(e) (nxt.Q + (size_t)r32 * QP + wid * D + ((e) >> 1) * 16 + hi * 8 + ((e) & 1) * 4)
    if constexpr (F32) { SLOAD_F((const float*)nxt.K, kbn); SBAR();
#pragma unroll
        for (int e = 0; e < 8; ++e) S.tq[e] = *(const f32x4*)QROW(e); }
    else { SLOAD_H(nxt.K, nxt.V, kbn); SBAR();
#pragma unroll
        for (int d0 = 0; d0 < 8; ++d0) S.qr[d0] = load8<TIn>(nxt.Q + (size_t)r32 * QP + wid * D + d0 * 16 + hi * 8); }
    SBAR();
    finishSM(pA0, pA1, alA, l_reg, pa0, pa1, pa2, pa3); SBAR();
    if constexpr (F32) {
#pragma unroll
        for (int e = 8; e < 16; ++e) S.tq[e] = *(const f32x4*)QROW(e); SBAR(); }
#undef QROW
    pv_tile<0, SK>(o, vb0, pa0, pa1, pa2, pa3, ACT(even ? NT - 2 : NT - 1));
    if (even) { MASKT(pB0, pB1, NT - 1); partialSM(pB0, pB1, m_reg, mnB, alB); __syncthreads(); RESC(alB);
        finishSM(pB0, pB1, alB, l_reg, pa0, pa1, pa2, pa3); SBAR(); pv_tile<1, SK>(o, vb0, pa0, pa1, pa2, pa3, ACT(NT - 1)); }
    SBAR(); SEAM_K0();
    if (hi == 0) li_l[r32] = l_reg; asm volatile("s_waitcnt lgkmcnt(0)" ::: "memory");
    float rli[16];
#pragma unroll
    for (int r = 0; r < 16; ++r) rli[r] = __builtin_amdgcn_rcpf(li_l[crow(r, hi)]);
    TOut* Ow = cur.O + wid * D;
#pragma unroll
    for (int r = 0; r < 16; ++r) { const int orow = crow(r, hi);
#pragma unroll
        for (int d0 = 0; d0 < 4; ++d0) { const float v = o[d0][r] * rli[r];
            if constexpr (same_t<TOut, float>::v) { Ow[(size_t)orow * OP + d0 * 32 + r32] = v; }
            else { const float vn = dpp_xor1(v);
                   if ((r32 & 1) == 0) *(unsigned*)(Ow + (size_t)orow * OP + d0 * 32 + r32) = cvtpk(v, vn); } } }
    if constexpr (F32) {
#pragma unroll
        for (int d0 = 0; d0 < 8; ++d0) S.qr[d0] = pack8(S.tq[2 * d0], S.tq[2 * d0 + 1]); }
    __syncthreads();
#undef RESC
#undef KBASE
#undef ACT
#undef MASKT
#undef SEAM_K0
#undef HALF_STEP
}
#undef ROW
#undef VMW
#undef VMWN
#undef SLOAD_H
#undef SWRITE_HK
#undef SWRITE_HV
#undef SWRITE_H
#undef SLOAD_F
#undef SWRITE_KF
#undef SWRITE_VF
}

constexpr int NWAVES = 8;
constexpr int BATCH = 2, SEQ = 8192, D = 4096, M = BATCH * SEQ;
constexpr int SELF_W = 3072, XA_W = 1024, MEM_LEN = 256, XA_HD = 256;
constexpr int PG = 768;
constexpr int HD = 128, NQH = 24, NKVH = 3, KV_W = 384, WINDOW = 128;
constexpr int N_IN1 = SELF_W + 2 * KV_W + XA_W;
constexpr int FF = 16384;
constexpr float EPS = 1e-6f;
constexpr int DUP_CONV = 1, DUP_UP = 1, DUP_PROJ = 1, DUP_SWA = 1, DUP_POOLP = 1;

constexpr size_t MiB = 1u << 20;
constexpr size_t WS_CTL = 0, CTL_ZERO_BYTES = 64 * 1024;
constexpr size_t WS_RSTD = 1 * MiB;
constexpr size_t WS_SSQP = 2 * MiB;
constexpr size_t WS_ROPE = 6 * MiB;
constexpr size_t WS_MEMN = 8 * MiB;
constexpr size_t WS_MEMK = 16 * MiB;
constexpr size_t WS_VT = 18 * MiB;
constexpr size_t WS_WKV = 20 * MiB;
constexpr size_t WS_WIN0 = 52 * MiB;
constexpr size_t WS_WG = 84 * MiB;
constexpr size_t WS_WOUT0 = 89 * MiB;
constexpr size_t WS_WIN1 = 121 * MiB;
constexpr size_t WS_WOUT1 = 159 * MiB;
constexpr size_t WS_W1 = 191 * MiB;
constexpr size_t WS_W2 = 447 * MiB;
constexpr size_t WS_XN = 703 * MiB;
constexpr size_t WS_PROJ = 831 * MiB;
constexpr size_t WS_PBUF = 983 * MiB;
constexpr size_t WS_PM = 1079 * MiB;
constexpr size_t WS_Y = 1111 * MiB;
constexpr size_t WS_HID = 1239 * MiB;
constexpr size_t WS_END = 1751 * MiB;
static_assert(WS_Y + (size_t)M * D * 2 <= WS_END && WS_HID + (size_t)M * FF * 2 <= WS_END, "ws map");

constexpr int CW_TMO = 0, CW_CODE = 1;
constexpr int CW_BAR = 4096;

constexpr int RING_OFF = 0, RING_BYTES = 131072;
constexpr int LDSCTL_OFF = RING_BYTES, MISC_OFF = LDSCTL_OFF + 320;
constexpr int LDS_BYTES = 147456;

#define GAS __attribute__((address_space(1)))
#define LAS __attribute__((address_space(3)))
typedef unsigned short bf16;
typedef unsigned v4u __attribute__((ext_vector_type(4)));
typedef unsigned v2u __attribute__((ext_vector_type(2)));
typedef float f32x4 __attribute__((ext_vector_type(4)));
typedef GAS unsigned gu32;
#define RLX_AGENT __ATOMIC_RELAXED, __HIP_MEMORY_SCOPE_AGENT
#define LDS_WAIT() asm volatile("s_waitcnt lgkmcnt(0)" ::: "memory")
#define VM_WAIT() asm volatile("s_waitcnt vmcnt(0)" ::: "memory")
__device__ __forceinline__ unsigned f2bf(float f) { unsigned u = __builtin_bit_cast(unsigned, f); return (u + 0x7fffu + ((u >> 16) & 1u)) >> 16; }
__device__ __forceinline__ unsigned pk2(float lo, float hi) { return f2bf(lo) | (f2bf(hi) << 16); }
__device__ __forceinline__ float bflo(unsigned w) { return __builtin_bit_cast(float, w << 16); }
__device__ __forceinline__ float bfhi(unsigned w) { return __builtin_bit_cast(float, w & 0xffff0000u); }

#define XB_TMO      128
#define XB_XCNT(j)  (256  + 64 * (j))
#define XB_XSUB(j)  (1280 + 64 * (j))
#define XB_XGEN(j)  (2304 + 64 * (j))
#define XB_TOP      3328
#define XB_TOPGEN   3392
#define XCD_BAR_WORDS 3456
#define XB_LSUB(j)  (3584 + 64 * (j))
#define XB_LGEN(j)  (4608 + 64 * (j))
#define XB_ALL_WORDS 5632
#define XB_SPIN_CAP (1u << 18)

__device__ __forceinline__ unsigned xb_ld(unsigned* p)              { return __hip_atomic_load(p, __ATOMIC_RELAXED, __HIP_MEMORY_SCOPE_AGENT); }
__device__ __forceinline__ unsigned xb_add(unsigned* p, unsigned v) { return __hip_atomic_fetch_add(p, v, __ATOMIC_RELAXED, __HIP_MEMORY_SCOPE_AGENT); }
__device__ __forceinline__ unsigned xb_xcc_id() { return (unsigned)__builtin_amdgcn_s_getreg((3 << 11) | 20) & 0xFu; }
#define XB_SPIN(cond, bar) do { unsigned _sp = 0; while (cond) { \
    if ((++_sp & 255u) == 0u) { if (xb_ld(&(bar)[XB_TMO])) break; if (_sp > XB_SPIN_CAP) { atomicAdd(&(bar)[XB_TMO], 1u); break; } } } } while (0)

struct XcdBarrier { unsigned* bar; unsigned x; volatile LAS unsigned* st; };

__device__ __forceinline__ XcdBarrier xcd_barrier_post(unsigned* bar, volatile LAS unsigned* st) {
    XcdBarrier b; b.bar = bar; b.x = xb_xcc_id(); b.st = st;
    if (threadIdx.x == 0) st[2] = xb_add(&bar[XB_XCNT(b.x)], 1u);
    return b;
}
__device__ __forceinline__ void xcd_barrier_complete(unsigned* bar, unsigned x, unsigned& nloc, unsigned& nx, unsigned& balanced) {
    const unsigned G = gridDim.x * gridDim.y * gridDim.z;
    unsigned sum, cnt, mine, sp = 0u, eq;
    for (;;) {
        sum = 0u; cnt = 0u; mine = 0u; eq = 1u;
#pragma unroll
        for (unsigned j = 0; j < 16; ++j) { const unsigned c = xb_ld(&bar[XB_XCNT(j)]); sum += c; cnt += (c > 0u) ? 1u : 0u; mine = (j == x) ? c : mine; eq &= (j < 8u) ? (c * 8u == G ? 1u : 0u) : (c == 0u ? 1u : 0u); }
        if (sum == G) break;
        __builtin_amdgcn_s_sleep(1);
        if ((++sp & 255u) == 0u) { if (xb_ld(&bar[XB_TMO])) break; if (sp > XB_SPIN_CAP) { atomicAdd(&bar[XB_TMO], 1u); break; } }
    }
    nloc = mine > 0u ? mine : 1u; nx = cnt > 0u ? cnt : 1u; balanced = (sum == G) ? eq : 0u;
}
template <bool FIRST> __device__ __forceinline__ void xcd_barrier(const XcdBarrier& b, const int t_) {
    asm volatile("s_waitcnt vmcnt(0)" ::: "memory");
    __syncthreads();
    if (t_ == 0) {
        unsigned* bar = b.bar; unsigned bx_ = b.x; asm volatile("" : "+s"(bx_));
        __builtin_amdgcn_s_waitcnt(0);
        unsigned nloc = b.st[0], nx = b.st[1];
        if constexpr (FIRST) { if (nloc == 0u) { unsigned bal_; xcd_barrier_complete(bar, bx_, nloc, nx, bal_); b.st[0] = nloc; b.st[1] = nx; b.st[3] = bal_; } }
        else { nloc = nloc ? nloc : 1u; nx = nx ? nx : 1u; }
        const unsigned old = xb_add(&bar[XB_XSUB(bx_)], 1u);
        const unsigned gen = old / nloc;
        if (old + 1u == (gen + 1u) * nloc) {
            __builtin_amdgcn_fence(__ATOMIC_RELEASE, "agent");
            asm volatile("s_waitcnt vmcnt(0)" ::: "memory");
            const unsigned og = xb_add(&bar[XB_TOP], 1u);
            const unsigned tg = og / nx;
            if (og + 1u == (tg + 1u) * nx) xb_add(&bar[XB_TOPGEN], 1u);
            else XB_SPIN(xb_ld(&bar[XB_TOPGEN]) == tg, bar);
            __builtin_amdgcn_fence(__ATOMIC_ACQUIRE, "agent");
            xb_add(&bar[XB_XGEN(bx_)], 1u);
            asm volatile("s_waitcnt vmcnt(0)" ::: "memory");
        } else {
            XB_SPIN(xb_ld(&bar[XB_XGEN(bx_)]) == gen, bar);
            __builtin_amdgcn_fence(__ATOMIC_ACQUIRE, "agent");
            asm volatile("s_waitcnt vmcnt(0)" ::: "memory");
        }
    }
    __syncthreads();
}

__device__ __forceinline__ void xcd_local_barrier(const XcdBarrier& b, const int t_) {
    asm volatile("s_waitcnt vmcnt(0)" ::: "memory");
    __syncthreads();
    if (t_ == 0) {
        unsigned* bar = b.bar; unsigned bx_ = b.x; asm volatile("" : "+s"(bx_));
        __builtin_amdgcn_s_waitcnt(0);
        unsigned nloc = b.st[0]; nloc = nloc ? nloc : 1u;
        const unsigned old = xb_add(&bar[XB_LSUB(bx_)], 1u);
        const unsigned gen = old / nloc;
        if (old + 1u == (gen + 1u) * nloc) {
            __builtin_amdgcn_fence(__ATOMIC_RELEASE, "agent");
            asm volatile("s_waitcnt vmcnt(0)" ::: "memory");
            __builtin_amdgcn_fence(__ATOMIC_ACQUIRE, "agent");
            xb_add(&bar[XB_LGEN(bx_)], 1u);
            asm volatile("s_waitcnt vmcnt(0)" ::: "memory");
        } else {
            XB_SPIN(xb_ld(&bar[XB_LGEN(bx_)]) == gen, bar);
            __builtin_amdgcn_fence(__ATOMIC_ACQUIRE, "agent");
            asm volatile("s_waitcnt vmcnt(0)" ::: "memory");
        }
    }
    __syncthreads();
}

__device__ __forceinline__ float wave_sum(float v) {
    v += SWZ_XOR(v, 1); v += SWZ_XOR(v, 2); v += SWZ_XOR(v, 4); v += SWZ_XOR(v, 8); v += SWZ_XOR(v, 16);
    return xor32_add(v);
}
__device__ __forceinline__ float wave_max(float v) {
    v = fmaxf(v, SWZ_XOR(v, 1)); v = fmaxf(v, SWZ_XOR(v, 2)); v = fmaxf(v, SWZ_XOR(v, 4)); v = fmaxf(v, SWZ_XOR(v, 8)); v = fmaxf(v, SWZ_XOR(v, 16));
    return xor32_max(v);
}

__device__ __forceinline__ float rope_inv_freq(int i) {
    float v = 1.000000000e+00f;
    v = (i == 1) ? 4.403665960e-01f : v; v = (i == 2) ? 1.939227432e-01f : v; v = (i == 3) ? 8.539710194e-02f : v; v = (i == 4) ? 3.760603070e-02f : v;
    v = (i == 5) ? 1.656044088e-02f : v; v = (i == 6) ? 7.292664610e-03f : v; v = (i == 7) ? 3.211446106e-03f : v; v = (i == 8) ? 1.414213562e-03f : v;
    v = (i == 9) ? 6.227724371e-04f : v; v = (i == 10) ? 2.742481884e-04f : v; v = (i == 11) ? 1.207697351e-04f : v; v = (i == 12) ? 5.318295734e-05f : v;
    v = (i == 13) ? 2.341999971e-05f : v; v = (i == 14) ? 1.031338525e-05f : v; v = (i == 15) ? 4.541670478e-06f : v;
    return v;
}
__device__ __forceinline__ void sincos_f32arg(float ang, float& s, float& c) {
    const double a = (double)ang; const double n = rint(a * 0.15915494309189535);
    const double r = fma(-n, 6.283185307179586, a) - n * 2.4492935982947064e-16;
    const double r2 = r * r; double ts = r, ss = r, tc = 1.0, cc = 1.0;
#pragma unroll
    for (int k = 1; k <= 13; ++k) { ts *= -r2 * (1.0 / (double)((2 * k) * (2 * k + 1))); ss += ts; tc *= -r2 * (1.0 / (double)((2 * k - 1) * (2 * k))); cc += tc; }
    s = (float)ss; c = (float)cc;
}

__device__ __forceinline__ void transpose_item(const float* W, int K, int N, bf16* WT, LAS float* scr, int item, int lane, const float* gk = nullptr, int ldn = 0) {
    const int nblk = N / 32, kb = item / nblk, nb = item % nblk, k0 = 64 * kb, n0 = 32 * nb; const int pitch = ldn ? ldn : N;
    const int c = lane & 7;
    f32x4 g0 = {1.f, 1.f, 1.f, 1.f}, g1 = {1.f, 1.f, 1.f, 1.f};
    if (gk) { g0 = *(const GAS f32x4*)(gk + k0 + 8 * c); g1 = *(const GAS f32x4*)(gk + k0 + 8 * c + 4); }
    { f32x4 v[8];
#pragma unroll
      for (int j = 0; j < 8; ++j) v[j] = *(const GAS f32x4*)(W + (size_t)(k0 + 8 * j + (lane >> 3)) * pitch + n0 + 4 * (lane & 7));
#pragma unroll
      for (int j = 0; j < 8; ++j) { LAS float* d = scr + (8 * j + (lane >> 3)) * 33 + 4 * (lane & 7); d[0] = v[j].x; d[1] = v[j].y; d[2] = v[j].z; d[3] = v[j].w; } }
    LDS_WAIT(); asm volatile("" ::: "memory");
#pragma unroll
    for (int j = 0; j < 4; ++j) { const int n = (lane >> 3) + 8 * j; const LAS float* s = scr + (8 * c) * 33 + n;
        v4u o; o.x = pk2(s[0 * 33] * g0.x, s[1 * 33] * g0.y); o.y = pk2(s[2 * 33] * g0.z, s[3 * 33] * g0.w); o.z = pk2(s[4 * 33] * g1.x, s[5 * 33] * g1.y); o.w = pk2(s[6 * 33] * g1.z, s[7 * 33] * g1.w);
        *(GAS v4u*)(WT + (size_t)(n0 + n) * K + k0 + 8 * c) = o; }
    LDS_WAIT(); asm volatile("" ::: "memory");
}

__device__ __forceinline__ float row_prep(const float* xrow, const float* g, bf16* orow, bool norm, int lane) {
    const GAS f32x4* xr = (const GAS f32x4*)xrow + lane;
    f32x4 v[16]; float s = 0.f;
#pragma unroll
    for (int j = 0; j < 16; ++j) { v[j] = xr[64 * j]; s += (v[j].x * v[j].x + v[j].y * v[j].y) + (v[j].z * v[j].z + v[j].w * v[j].w); }
    const float rstd = 1.0f / sqrtf(wave_sum(s) * (1.f / D) + EPS);
    const float sc = norm ? rstd : 1.0f;
    const GAS f32x4* gr = (const GAS f32x4*)g + lane;
    GAS v2u* o8 = (GAS v2u*)orow + lane;
#pragma unroll
    for (int j = 0; j < 16; ++j) { const f32x4 gg = g ? gr[64 * j] : (f32x4){1.f, 1.f, 1.f, 1.f}; v2u o; o.x = pk2(v[j].x * gg.x * sc, v[j].y * gg.y * sc); o.y = pk2(v[j].z * gg.z * sc, v[j].w * gg.w * sc); o8[64 * j] = o; }
    return rstd;
}

using pg8::Unit; using pg8::bf16_t;
template <int MODE> struct EpiRowScale {
    static constexpr bool AFTER_DRAIN = false;
    bf16_t* O; int ldc; const float* rstd; const float* cosT; const float* sinT;
    __device__ __forceinline__ void operator()(const f32x4 (&acc)[2][2][4][2], const Unit& u, int wr, int wc, int fr, int fq) const {
        const int row0 = u.pm * 256 + wr * 64 + fr, col0 = u.pn * 256 + wc * 32 + 8 * fq;
        float rsv[2][4];
#pragma unroll
        for (int ai = 0; ai < 2; ++ai)
#pragma unroll
            for (int m = 0; m < 4; ++m) rsv[ai][m] = rstd[row0 + ai * 128 + m * 16];
        f32x4 tn[3][4];
        const bool rope = (MODE == 2) && (wc == 0);
#define ROPE_LD(dst, g_) do { const int r_ = row0 + ((g_) >> 2) * 128 + ((g_) & 3) * 16; const float* cp_ = cosT + (size_t)r_ * 16 + 8 * (fq & 1); const float* sp_ = sinT + (size_t)r_ * 16 + 8 * (fq & 1); \
        dst[0] = *(const f32x4*)cp_; dst[1] = *(const f32x4*)(cp_ + 4); dst[2] = *(const f32x4*)sp_; dst[3] = *(const f32x4*)(sp_ + 4); } while (0)
        if (MODE == 2) { if (rope) { ROPE_LD(tn[0], 0); ROPE_LD(tn[1], 1); ROPE_LD(tn[2], 2); } }
#pragma unroll
        for (int ai = 0; ai < 2; ++ai)
#pragma unroll
            for (int m = 0; m < 4; ++m) { const int row = row0 + ai * 128 + m * 16; const float rs = rsv[ai][m]; bf16_t* rowp = O + (size_t)row * ldc + col0;
                f32x4 c0, c1, s0, s1;
                if (MODE == 2) { if (rope) { constexpr int RB = 0; (void)RB; const int g_ = ai * 4 + m; c0 = tn[g_ % 3][0]; c1 = tn[g_ % 3][1]; s0 = tn[g_ % 3][2]; s1 = tn[g_ % 3][3]; if (fq < 2) { s0 = -s0; s1 = -s1; }
                    if (g_ + 3 < 8) ROPE_LD(tn[g_ % 3], g_ + 3); } }
#pragma unroll
                for (int bj = 0; bj < 2; ++bj) { f32x4 v0 = acc[ai][bj][m][0] * rs, v1 = acc[ai][bj][m][1] * rs;
                    if (MODE == 1) {
#pragma unroll
                        for (int j = 0; j < 4; ++j) { const float a = fmaxf(v0[j], 0.f), b = fmaxf(v1[j], 0.f); v0[j] = a * a; v1[j] = b * b; } }
                    if (MODE == 2) { if (wc == 0 && (2 * u.pn + bj) < 27) {
                        f32x4 o0, o1;
#pragma unroll
                        for (int j = 0; j < 4; ++j) { o0[j] = xor32_other(v0[j], fq < 2); o1[j] = xor32_other(v1[j], fq < 2); }
                        v0 = v0 * c0 + o0 * s0; v1 = v1 * c1 + o1 * s1; } }
                    pg8::st_bf16x8(rowp + bj * 128, v0, v1); } }
#undef ROPE_LD
    }
};
template <bool BASE_F32, bool OUT_F32> struct EpiResid {
    static constexpr bool AFTER_DRAIN = false;
    const void* base; void* out; float* ssqp;
    __device__ __forceinline__ void operator()(const f32x4 (&acc)[2][2][4][2], const Unit& u, int wr, int wc, int fr, int fq) const {
        const int row0 = u.pm * 256 + wr * 64 + fr, col0 = u.pn * 256 + wc * 32 + 8 * fq;
#pragma unroll
        for (int ai = 0; ai < 2; ++ai) {
            f32x4 bf[BASE_F32 ? 4 : 1][2][2]; pg8::u32x4 bq[BASE_F32 ? 1 : 4][2];
#pragma unroll
            for (int m = 0; m < 4; ++m)
#pragma unroll
                for (int bj = 0; bj < 2; ++bj) { const size_t off = (size_t)(row0 + ai * 128 + m * 16) * D + col0 + bj * 128;
                    if (BASE_F32) { bf[m][bj][0] = *(const f32x4*)((const float*)base + off); bf[m][bj][1] = *(const f32x4*)((const float*)base + off + 4); }
                    else bq[m][bj] = *(const pg8::u32x4*)((const bf16_t*)base + off); }
#pragma unroll
            for (int m = 0; m < 4; ++m) { const int row = row0 + ai * 128 + m * 16; const size_t off = (size_t)row * D + col0; float ss = 0.f;
#pragma unroll
                for (int bj = 0; bj < 2; ++bj) { f32x4 b0, b1;
                    if (BASE_F32) { b0 = bf[m][bj][0]; b1 = bf[m][bj][1]; }
                    else { const pg8::u32x4 w = bq[m][bj];
                        b0 = (f32x4){__uint_as_float(w.x << 16), __uint_as_float(w.x & 0xffff0000u), __uint_as_float(w.y << 16), __uint_as_float(w.y & 0xffff0000u)};
                        b1 = (f32x4){__uint_as_float(w.z << 16), __uint_as_float(w.z & 0xffff0000u), __uint_as_float(w.w << 16), __uint_as_float(w.w & 0xffff0000u)}; }
                    const f32x4 h0 = b0 + acc[ai][bj][m][0], h1 = b1 + acc[ai][bj][m][1];
                    ss += (h0[0] * h0[0] + h0[1] * h0[1]) + (h0[2] * h0[2] + h0[3] * h0[3]) + (h1[0] * h1[0] + h1[1] * h1[1]) + (h1[2] * h1[2] + h1[3] * h1[3]);
                    if (OUT_F32) { *(f32x4*)((float*)out + off + bj * 128) = h0; *(f32x4*)((float*)out + off + bj * 128 + 4) = h1; }
                    else pg8::st_bf16x8((bf16_t*)out + off + bj * 128, h0, h1); }
                ss = xor32_add(xor16_add(ss));
                if (fq == 0) ssqp[(size_t)row * 64 + u.pn * 4 + wc] = ss; }
            asm volatile("" ::: "memory"); }
    }
};
struct EpiPool {
    static constexpr bool AFTER_DRAIN = false;
    bf16_t* Y; const float* scale;
    __device__ __forceinline__ void operator()(const f32x4 (&acc)[2][2][4][2], const Unit& u, int wr, int wc, int fr, int fq) const {
        const int row0 = u.pm * 256 + wr * 64 + fr, col0 = u.z * PG + u.pn * 256 + wc * 32 + 8 * fq;
        f32x4 sv[2][2];
#pragma unroll
        for (int bj = 0; bj < 2; ++bj) { sv[bj][0] = *(const f32x4*)(scale + col0 + bj * 128); sv[bj][1] = *(const f32x4*)(scale + col0 + bj * 128 + 4); }
#pragma unroll
        for (int ai = 0; ai < 2; ++ai)
#pragma unroll
            for (int m = 0; m < 4; ++m) { bf16_t* rowp = Y + (size_t)(row0 + ai * 128 + m * 16) * D + col0;
#pragma unroll
                for (int bj = 0; bj < 2; ++bj) pg8::st_bf16x8(rowp + bj * 128, acc[ai][bj][m][0] * sv[bj][0], acc[ai][bj][m][1] * sv[bj][1]); }
    }
};
struct EpiMemKV {
    static constexpr bool AFTER_DRAIN = false;
    bf16_t* memk; bf16_t* vt;
    __device__ __forceinline__ void operator()(const f32x4 (&acc)[2][2][4][2], const Unit& u, int wr, int wc, int fr, int fq) const {
        const int layer = u.z >> 1, part = u.z & 1; const int ldc = part ? 512 : 1024;
        bf16_t* O = part ? vt + (size_t)layer * 1024 * 512 : memk + (size_t)layer * 512 * 1024;
        const int row0 = u.pm * 256 + wr * 64 + fr, col0 = u.pn * 256 + wc * 32 + 8 * fq;
#pragma unroll
        for (int ai = 0; ai < 2; ++ai)
#pragma unroll
            for (int m = 0; m < 4; ++m) { bf16_t* rowp = O + (size_t)(row0 + ai * 128 + m * 16) * ldc + col0;
#pragma unroll
                for (int bj = 0; bj < 2; ++bj) pg8::st_bf16x8(rowp + bj * 128, acc[ai][bj][m][0], acc[ai][bj][m][1]); }
    }
};

struct EpiXS {
    static constexpr bool AFTER_DRAIN = true;
    bf16_t* PM;
    __device__ __forceinline__ void fused(f32x4 (&acc)[2][2][4][2], const Unit& u, int wr, int wc, int fr, int fq, PG8_LAS unsigned char* lds, int wid, int lane) const {
        typedef float f32x2v __attribute__((ext_vector_type(2)));
        PG8_LAS f32x2v* T = (PG8_LAS f32x2v*)lds;
        const float c2 = 0.0625f * 1.4426950408889634f;
        float wm[2][4];
#pragma unroll
        for (int ai = 0; ai < 2; ++ai)
#pragma unroll
            for (int m = 0; m < 4; ++m) {
                float mx = -__builtin_inff();
#pragma unroll
                for (int bj = 0; bj < 2; ++bj)
#pragma unroll
                    for (int n = 0; n < 2; ++n) { const f32x4 v = acc[ai][bj][m][n]; mx = fmaxf(mx, fmaxf(fmaxf(v[0], v[1]), fmaxf(v[2], v[3]))); }
                mx = xor32_max(xor16_max(mx));
                float sm = 0.f;
#pragma unroll
                for (int bj = 0; bj < 2; ++bj)
#pragma unroll
                    for (int n = 0; n < 2; ++n) { f32x4 v = acc[ai][bj][m][n];
#pragma unroll
                        for (int j = 0; j < 4; ++j) { v[j] = __builtin_amdgcn_exp2f((v[j] - mx) * c2); sm += v[j]; }
                        acc[ai][bj][m][n] = v; }
                sm = xor32_add(xor16_add(sm));
                wm[ai][m] = mx;
                if (fq == 0) T[(ai * 128 + wr * 64 + m * 16 + fr) * 4 + wc] = (f32x2v){mx, sm};
            }
        asm volatile("s_waitcnt lgkmcnt(0)" ::: "memory"); __builtin_amdgcn_s_barrier(); asm volatile("" ::: "memory");
#pragma unroll
        for (int ai = 0; ai < 2; ++ai)
#pragma unroll
            for (int m = 0; m < 4; ++m) { const int r = ai * 128 + wr * 64 + m * 16 + fr;
                const f32x2v t0 = T[r * 4 + 0], t1 = T[r * 4 + 1], t2 = T[r * 4 + 2], t3 = T[r * 4 + 3];
                const float M = fmaxf(fmaxf(t0.x, t1.x), fmaxf(t2.x, t3.x));
                const float tot = (t0.y * __builtin_amdgcn_exp2f((t0.x - M) * c2) + t1.y * __builtin_amdgcn_exp2f((t1.x - M) * c2)) + (t2.y * __builtin_amdgcn_exp2f((t2.x - M) * c2) + t3.y * __builtin_amdgcn_exp2f((t3.x - M) * c2));
                const float f = __builtin_amdgcn_exp2f((wm[ai][m] - M) * c2) / tot;
                bf16_t* rowp = PM + (size_t)(u.pm * 256 + r) * XA_W + u.z * XA_HD + wc * 32 + 8 * fq;
#pragma unroll
                for (int bj = 0; bj < 2; ++bj) pg8::st_bf16x8(rowp + bj * 128, acc[ai][bj][m][0] * f, acc[ai][bj][m][1] * f); }
        asm volatile("s_waitcnt lgkmcnt(0)" ::: "memory"); __builtin_amdgcn_s_barrier(); asm volatile("" ::: "memory");
    }
};
struct EpiXV {
    static constexpr bool AFTER_DRAIN = false;
    bf16_t* Y;
    __device__ __forceinline__ void operator()(const f32x4 (&acc)[2][2][4][2], const Unit& u, int wr, int wc, int fr, int fq) const {
        const int row0 = u.pm * 256 + wr * 64 + fr, col0 = SELF_W + u.z * XA_HD + wc * 32 + 8 * fq;
#pragma unroll
        for (int ai = 0; ai < 2; ++ai)
#pragma unroll
            for (int m = 0; m < 4; ++m) { bf16_t* rowp = Y + (size_t)(row0 + ai * 128 + m * 16) * D + col0;
#pragma unroll
                for (int bj = 0; bj < 2; ++bj) pg8::st_bf16x8(rowp + bj * 128, acc[ai][bj][m][0], acc[ai][bj][m][1]); }
    }
};
struct XOrder {
    int G, c, i0; bool one; const char* A; size_t lda; size_t a_hoff; const char* B; size_t b_boff, b_hoff;
    __device__ __forceinline__ bool next(int i, Unit& u) const {
        if (one && i > 0) return false;
        const int L = (i + i0) * G + c; if (L >= 256) return false;
        const int b = L >> 7, h = (L >> 5) & 3, rp = L & 31; u.pm = b * 32 + rp; u.pn = 0; u.z = h;
        u.a = A + (size_t)u.pm * 256 * lda + (size_t)h * a_hoff; u.b = B + (size_t)b * b_boff + (size_t)h * b_hoff; return true;
    }
};

struct EpiProd {
    static constexpr bool AFTER_DRAIN = false;
    bf16_t* WT; const float* rscale; const float* cgain;
    __device__ __forceinline__ void operator()(const f32x4 (&acc)[2][2][4][2], const Unit& u, int wr, int wc, int fr, int fq) const {
        const int row0 = u.z * PG + u.pm * 256 + wr * 64 + fr, col0 = u.pn * 256 + wc * 32 + 8 * fq;
        float rs[2][4]; f32x4 cg[2][2];
#pragma unroll
        for (int ai = 0; ai < 2; ++ai)
#pragma unroll
            for (int m = 0; m < 4; ++m) rs[ai][m] = rscale[row0 + ai * 128 + m * 16];
#pragma unroll
        for (int bj = 0; bj < 2; ++bj) { cg[bj][0] = *(const f32x4*)(cgain + col0 + bj * 128); cg[bj][1] = *(const f32x4*)(cgain + col0 + bj * 128 + 4); }
#pragma unroll
        for (int ai = 0; ai < 2; ++ai)
#pragma unroll
            for (int m = 0; m < 4; ++m) { bf16_t* rowp = WT + (size_t)(row0 + ai * 128 + m * 16) * D + col0;
#pragma unroll
                for (int bj = 0; bj < 2; ++bj) pg8::st_bf16x8(rowp + bj * 128, acc[ai][bj][m][0] * rs[ai][m] * cg[bj][0], acc[ai][bj][m][1] * rs[ai][m] * cg[bj][1]); }
    }
};
struct ProdOrder {
    int G, c; const char* wgt; const char* winn;
    __device__ __forceinline__ bool next(int i, Unit& u) const {
        const int L = i * G + c; if (L >= 192) return false;
        const int g = L / 48, r = L - g * 48; u.z = g; u.pm = r >> 4; u.pn = r & 15;
        u.a = wgt + (size_t)(g * PG + u.pm * 256) * (PG * 2); u.b = winn + (size_t)(u.pn * 256) * (SELF_W * 2) + (size_t)g * PG * 2; return true;
    }
};

struct MemKVOrder {
    int G, c; const char* memn; const char* wkv;
    __device__ __forceinline__ bool next(int i, Unit& u) const {
        const int L = i * G + c; if (L >= 32) return false;
        const int layer = L >> 4, part = (L >> 3) & 1, q = L & 7;
        const char* mn = memn + (size_t)layer * 512 * 8192; const char* w = wkv + (size_t)layer * 2048 * 8192;
        if (part == 0) { u.pm = q >> 2; u.pn = q & 3; u.a = mn + (size_t)u.pm * 256 * 8192; u.b = w + (size_t)u.pn * 256 * 8192; }
        else { u.pm = q >> 1; u.pn = q & 1; u.a = w + (size_t)(1024 + u.pm * 256) * 8192; u.b = mn + (size_t)u.pn * 256 * 8192; }
        u.z = layer * 2 + part; return true;
    }
};
struct PoolOrder {
    int G, c; const char* pbuf; const char* wg;
    __device__ __forceinline__ bool next(int i, Unit& u) const {
        const int L = i * G + c; if (L >= 768) return false;
        u.pn = L % 3; const int g = (L / 3) & 3; u.pm = L / 12; u.z = g;
        u.a = pbuf + (size_t)u.pm * 256 * (SELF_W * 2) + (size_t)g * PG * 2; u.b = wg + (size_t)(g * PG + u.pn * 256) * (PG * 2); return true;
    }
};

struct Args { const void* in[17]; float* out; unsigned char* ws; };

__global__ void __launch_bounds__(NWAVES * 64, 2) fwd_kernel(Args args_unused) {
    extern __shared__ __attribute__((aligned(16))) unsigned char lds_raw[];
    LAS unsigned char* lds = (LAS unsigned char*)lds_raw;
    volatile LAS unsigned* MISC = (volatile LAS unsigned*)(lds + MISC_OFF);
    const int tid0 = threadIdx.x;
    const int wave0 = __builtin_amdgcn_readfirstlane(tid0 >> 6);
#define PHASE_TID() int wave = wave0; asm volatile("" : "+s"(wave)); int lane; asm volatile("v_mbcnt_lo_u32_b32 %0, -1, 0\n\tv_mbcnt_hi_u32_b32 %0, -1, %0" : "=v"(lane)); \
    const int tid = wave * 64 + lane; (void)tid
#define KARG(i) (*(const void* const __attribute__((address_space(4)))*)(kp + 8 * (i)))
#define PHASE_IDS() PHASE_TID(); \
    int G = gridDim.x, bx = __builtin_amdgcn_readfirstlane((int)MISC[12]); asm volatile("" : "+s"(G), "+s"(bx));     const int vcu = (G % 8 == 0) ? (bx % 8) * (G / 8) + bx / 8 : bx; (void)vcu; \
    LAS float* scr = (LAS float*)(lds + RING_OFF + wave * 16384); (void)scr; \
    const __attribute__((address_space(4))) char* kp = (const __attribute__((address_space(4))) char*)__builtin_amdgcn_kernarg_segment_ptr(); asm volatile("" : "+s"(kp)); \
    const float* x = (const float*)KARG(0); const float* mem = (const float*)KARG(1); const int* positions = (const int*)KARG(2); \
    const float* norm_mix = (const float*)KARG(3); const float* norm_mem = (const float*)KARG(4); const float* norm_mlp = (const float*)KARG(5); \
    const float* w_mem_kv = (const float*)KARG(6); const float* pool_w_in = (const float*)KARG(7); const float* pool_w_group = (const float*)KARG(8); \
    const float* pool_scale = (const float*)KARG(9); const float* pool_w_out = (const float*)KARG(10); const float* attn_w_in = (const float*)KARG(11); \
    const float* attn_sink = (const float*)KARG(12); const float* attn_w_out = (const float*)KARG(13); const float* mlp_w1 = (const float*)KARG(14); \
    const float* mlp_w2 = (const float*)KARG(15); const float* final_norm = (const float*)KARG(16); float* out = (float*)KARG(17); unsigned char* ws = (unsigned char*)KARG(18); \
    (void)x; (void)mem; (void)positions; (void)norm_mix; (void)norm_mem; (void)norm_mlp; (void)w_mem_kv; (void)pool_w_in; (void)pool_w_group; (void)pool_scale; (void)pool_w_out; \
    (void)attn_w_in; (void)attn_sink; (void)attn_w_out; (void)mlp_w1; (void)mlp_w2; (void)final_norm; (void)out; \
    gu32* ctl = (gu32*)(ws + WS_CTL); (void)ctl; \
    float* RSTD = (float*)(ws + WS_RSTD); float* SSQP = (float*)(ws + WS_SSQP); float* COS = (float*)(ws + WS_ROPE); float* SIN = COS + (size_t)M * 16; \
    bf16* MEMN = (bf16*)(ws + WS_MEMN); bf16* MEMK = (bf16*)(ws + WS_MEMK); bf16* VT = (bf16*)(ws + WS_VT); \
    bf16* WKV = (bf16*)(ws + WS_WKV); bf16* WIN0 = (bf16*)(ws + WS_WIN0); bf16* WGT = (bf16*)(ws + WS_WG); bf16* WOUT0 = (bf16*)(ws + WS_WOUT0); \
    bf16* WIN1 = (bf16*)(ws + WS_WIN1); bf16* WOUT1 = (bf16*)(ws + WS_WOUT1); bf16* W1T = (bf16*)(ws + WS_W1); bf16* W2T = (bf16*)(ws + WS_W2); \
    bf16* XN = (bf16*)(ws + WS_XN); bf16* PROJ = (bf16*)(ws + WS_PROJ); bf16* PBUF = (bf16*)(ws + WS_PBUF); bf16* PM = (bf16*)(ws + WS_PM); \
    bf16* Y = (bf16*)(ws + WS_Y); bf16* HID = (bf16*)(ws + WS_HID); \
    (void)RSTD; (void)SSQP; (void)COS; (void)SIN; (void)MEMN; (void)MEMK; (void)VT; (void)WKV; (void)WIN0; (void)WGT; (void)WOUT0; (void)WIN1; (void)WOUT1; (void)W1T; (void)W2T; \
    (void)XN; (void)PROJ; (void)PBUF; (void)PM; (void)Y; (void)HID
    for (int u = tid0; u < (LDS_BYTES - LDSCTL_OFF) / 4; u += NWAVES * 64) ((LAS unsigned*)(lds + LDSCTL_OFF))[u] = 0u;
    __syncthreads();
    if (tid0 == 0) MISC[12] = blockIdx.x;
    __syncthreads();
    XcdBarrier bar;
    { const __attribute__((address_space(4))) char* kp = (const __attribute__((address_space(4))) char*)__builtin_amdgcn_kernarg_segment_ptr();
      unsigned char* ws0 = (unsigned char*)KARG(18); bar = xcd_barrier_post((unsigned*)((gu32*)(ws0 + WS_CTL) + CW_BAR), MISC + 8); }
#define GRID_BAR() do { PHASE_TID(); xcd_barrier<false>(bar, tid); } while (0)
#define GRID_BAR_FIRST() do { PHASE_TID(); xcd_barrier<true>(bar, tid); if (tid == 0) { const unsigned bal_ = (MISC[11] != 0u && gridDim.x == 256u) ? 1u : 0u; MISC[13] = bal_; if (bal_) MISC[12] = bar.x + 8u * MISC[10]; } __syncthreads(); } while (0)
#define LOCAL_BAR() do { PHASE_TID(); if (__builtin_amdgcn_readfirstlane((int)MISC[13])) xcd_local_barrier(bar, tid); else xcd_barrier<false>(bar, tid); } while (0)

    {
        PHASE_IDS();
        const int gw = vcu * NWAVES + wave, NGW = G * NWAVES;
        constexpr int I_KV = (D / 64) * (2048 / 32);
        for (int it = gw; it < 2 * I_KV; it += NGW) { const int l = it / I_KV, r = it % I_KV; transpose_item(w_mem_kv + (size_t)l * D * 2048, D, 2048, WKV + (size_t)l * 2048 * D, scr, r, lane); }
        for (int it = gw; it < 2 * 512; it += NGW) { const int l = it >> 9, r = it & 511; (void)row_prep(mem + (size_t)r * D, norm_mem + (size_t)l * D, MEMN + ((size_t)l * 512 + r) * D, true, lane); }
        constexpr int I_G = (PG / 64) * (PG / 32);
        for (int it = gw; it < 4 * I_G; it += NGW) { const int g = it / I_G; transpose_item(pool_w_group + (size_t)g * PG * PG, PG, PG, WGT + (size_t)g * PG * PG, scr, it % I_G, lane); }
        for (int e0 = vcu * 512 + tid; e0 < D * (SELF_W / 8); e0 += 4 * G * 512) {
            f32x4 a[4], b[4];
#pragma unroll
            for (int u = 0; u < 4; ++u) { const int e = e0 + u * G * 512; const int ee = (e < D * (SELF_W / 8)) ? e : e0; const int k = ee / (SELF_W / 8), c8 = (ee % (SELF_W / 8)) * 8;
                a[u] = *(const GAS f32x4*)(pool_w_in + (size_t)k * D + c8); b[u] = *(const GAS f32x4*)(pool_w_in + (size_t)k * D + c8 + 4); }
#pragma unroll
            for (int u = 0; u < 4; ++u) { const int e = e0 + u * G * 512; if (e < D * (SELF_W / 8)) { const int k = e / (SELF_W / 8), c8 = (e % (SELF_W / 8)) * 8;
                v4u o; o.x = pk2(a[u].x, a[u].y); o.y = pk2(a[u].z, a[u].w); o.z = pk2(b[u].x, b[u].y); o.w = pk2(b[u].z, b[u].w); *(GAS v4u*)(PBUF + (size_t)k * SELF_W + c8) = o; } } }
    }
    GRID_BAR_FIRST();
    {
        PHASE_IDS();
        const int ngemm = (G >= 64) ? 32 : G;
        if (vcu < ngemm) {
            MemKVOrder S; S.G = ngemm; S.c = vcu; S.memn = (const char*)MEMN; S.wkv = (const char*)WKV;
            EpiMemKV E{MEMK, VT};
            pg8::gemm_phase<EpiMemKV, MemKVOrder>(lds + RING_OFF, tid, 8192u, 8192u, D / 64, S, E);
            __syncthreads();
        }
        if (G >= 64 && vcu < ngemm) {
            PHASE_IDS();
            ProdOrder S; S.G = 32; S.c = vcu; S.wgt = (const char*)WGT; S.winn = (const char*)PBUF; EpiProd E{WIN0, pool_scale, norm_mix};
            pg8::gemm_phase<EpiProd, ProdOrder>(lds + RING_OFF, tid, PG * 2, SELF_W * 2, PG / 64, S, E); __syncthreads();
        }
        if (G < 64 || vcu >= ngemm) {
            const int cw = (G < 64) ? vcu : vcu - ngemm, ncw = (G < 64) ? G : G - ngemm;
            if (G < 64) { ProdOrder S; S.G = ncw; S.c = cw; S.wgt = (const char*)WGT; S.winn = (const char*)PBUF; EpiProd E{WIN0, pool_scale, norm_mix};
              pg8::gemm_phase<EpiProd, ProdOrder>(lds + RING_OFF, tid, PG * 2, SELF_W * 2, PG / 64, S, E); __syncthreads(); }
            const int gw = cw * NWAVES + wave, NGW = ncw * NWAVES;
            constexpr int I_SQ = (D / 64) * (D / 32), I_G = (PG / 64) * (PG / 32), I_IN1 = (D / 64) * (N_IN1 / 32), I_W1 = (D / 64) * (FF / 32), I_W2 = (FF / 64) * (D / 32);
            constexpr int I_XQ = (D / 64) * (XA_W / 32); (void)I_G;
            constexpr int NITEMS = 2 * I_SQ + I_XQ + I_IN1 + 2 * I_W1 + 2 * I_W2;
            for (int rep = 0; rep < DUP_CONV; ++rep)
            for (int it = gw; it < NITEMS; it += NGW) {
                int r = it;
                if (r < 2 * I_W1) { const int l = r / I_W1; transpose_item(mlp_w1 + (size_t)l * D * FF, D, FF, W1T + (size_t)l * FF * D, scr, r % I_W1, lane, norm_mlp + (size_t)l * D); continue; } r -= 2 * I_W1;
                if (r < 2 * I_W2) { const int l = r / I_W2; transpose_item(mlp_w2 + (size_t)l * FF * D, FF, D, W2T + (size_t)l * D * FF, scr, r % I_W2, lane); continue; } r -= 2 * I_W2;
                if (r < I_XQ) { transpose_item(pool_w_in + SELF_W, D, XA_W, WIN0 + (size_t)SELF_W * D, scr, r, lane, norm_mix, D); continue; } r -= I_XQ;
                if (r < I_SQ) { transpose_item(pool_w_out, D, D, WOUT0, scr, r, lane); continue; } r -= I_SQ;
                if (r < I_SQ) { transpose_item(attn_w_out, D, D, WOUT1, scr, r, lane); continue; } r -= I_SQ;
                transpose_item(attn_w_in, D, N_IN1, WIN1, scr, r, lane, norm_mix + D);
            }
            for (int m = gw; m < M; m += NGW) { const float rs = row_prep(x + (size_t)m * D, nullptr, XN + (size_t)m * D, false, lane); if (lane == 0) RSTD[m] = rs; }
            for (int e = cw * 512 + tid; e < M * 16; e += ncw * 512) { const int m = e >> 4, i = e & 15;
                const float ang = (float)positions[m] * rope_inv_freq(i);
                float sn, cs; sincos_f32arg(ang, sn, cs); COS[e] = cs; SIN[e] = sn; }
        }
    }
    GRID_BAR();

    for (int layer = 0; layer < 2; ++layer) {
        const int ldp = (layer == 0) ? D : N_IN1;
        const int xq_off = (layer == 0) ? SELF_W : SELF_W + 2 * KV_W;
        if (layer == 0) {
            for (int rep = 0; rep < DUP_PROJ; ++rep)
            { PHASE_IDS(); pg8::GridOrder S; S.init(M, D, G, bx, XN, D * 2, WIN0, D * 2); EpiRowScale<0> E{PROJ, D, RSTD, nullptr, nullptr};
              pg8::gemm_phase<EpiRowScale<0>, pg8::GridOrder>(lds + RING_OFF, tid, D * 2, D * 2, D / 64, S, E); }
            GRID_BAR();
            { PHASE_IDS();
            const int NITEM = (M / 32) * (SELF_W / 8), ipw = (NITEM + G - 1) / G;
            for (int li = tid; li < ipw; li += 512) { const int item = vcu * ipw + li; if (item >= NITEM) break;
                const int c8 = (item % (SELF_W / 8)) * 8, t0 = (item / (SELF_W / 8)) * 32; const int g = c8 / PG, w = 2 << g, pos0 = t0 & (SEQ - 1);
                const bf16* p = PROJ + (size_t)t0 * D + c8; bf16* q = Y + (size_t)t0 * D + c8;
                float s[8] = {0.f, 0.f, 0.f, 0.f, 0.f, 0.f, 0.f, 0.f};
                {
                    v4u vi[16];
#pragma unroll
                    for (int i = 1; i <= 16; ++i) { const int ii = (i <= w) ? i : w; const int back = (ii <= pos0) ? ii : 0; vi[i - 1] = *(const GAS v4u*)(p - (size_t)back * D); }
#pragma unroll
                    for (int i = 1; i <= 16; ++i) { const float mk = (i <= w && i <= pos0) ? 1.f : 0.f; const v4u v = vi[i - 1];
                        s[0] += mk * bflo(v.x); s[1] += mk * bfhi(v.x); s[2] += mk * bflo(v.y); s[3] += mk * bfhi(v.y); s[4] += mk * bflo(v.z); s[5] += mk * bfhi(v.z); s[6] += mk * bflo(v.w); s[7] += mk * bfhi(v.w); }
                }
#pragma unroll 1
                for (int r0 = 0; r0 < 32; r0 += 8) {
                    v4u vn[8], vo[8];
#pragma unroll
                    for (int j = 0; j < 8; ++j) vn[j] = *(const GAS v4u*)(p + (size_t)(r0 + j) * D);
#pragma unroll
                    for (int j = 0; j < 8; ++j) { const int pos = pos0 + r0 + j; const int rr = (pos >= w) ? r0 + j - w : r0 + j; vo[j] = *(const GAS v4u*)(p + (long)rr * D); }
#pragma unroll
                    for (int j = 0; j < 8; ++j) { const int pos = pos0 + r0 + j; const float mk = (pos >= w) ? 1.f : 0.f; const v4u v = vn[j], ov = vo[j];
                        const float u0[8] = {bflo(v.x), bfhi(v.x), bflo(v.y), bfhi(v.y), bflo(v.z), bfhi(v.z), bflo(v.w), bfhi(v.w)};
                        const float o0[8] = {bflo(ov.x), bfhi(ov.x), bflo(ov.y), bfhi(ov.y), bflo(ov.z), bfhi(ov.z), bflo(ov.w), bfhi(ov.w)};
#pragma unroll
                        for (int e = 0; e < 8; ++e) s[e] = (s[e] + u0[e]) - mk * o0[e];
                        const int cnt = (pos + 1 < w) ? pos + 1 : w; const float ic = 1.0f / (float)cnt; v4u o;
                        o.x = pk2(s[0] * ic - u0[0], s[1] * ic - u0[1]); o.y = pk2(s[2] * ic - u0[2], s[3] * ic - u0[3]); o.z = pk2(s[4] * ic - u0[4], s[5] * ic - u0[5]); o.w = pk2(s[6] * ic - u0[6], s[7] * ic - u0[7]);
                        *(GAS v4u*)(q + (size_t)(r0 + j) * D) = o; }
                }
            } }
            {
              for (int i0 = 0; ; ++i0) {
                  PHASE_IDS(); if (i0 * G + vcu >= 256) break;
                  XOrder S; S.G = G; S.c = vcu; S.i0 = i0; S.one = true; S.A = (const char*)PROJ + (size_t)xq_off * 2; S.lda = (size_t)ldp * 2; S.a_hoff = XA_HD * 2;
                  S.B = (const char*)(MEMK + (size_t)layer * 512 * 1024); S.b_boff = (size_t)256 * 1024 * 2; S.b_hoff = XA_HD * 2;
                  EpiXS E{PM};
                  pg8::gemm_phase<EpiXS, XOrder>(lds + RING_OFF, tid, (unsigned)(ldp * 2), 2048u, 4, S, E); }
              VM_WAIT(); __syncthreads(); }
            { PHASE_IDS();
              XOrder S; S.G = G; S.c = vcu; S.i0 = 0; S.one = false; S.A = (const char*)PM; S.lda = XA_W * 2; S.a_hoff = XA_HD * 2;
              S.B = (const char*)(VT + (size_t)layer * 1024 * 512); S.b_boff = 256 * 2; S.b_hoff = (size_t)XA_HD * 512 * 2;
              EpiXV E{Y};
              pg8::gemm_phase<EpiXV, XOrder>(lds + RING_OFF, tid, XA_W * 2, 1024u, 4, S, E); }
        } else {
            for (int rep = 0; rep < DUP_PROJ; ++rep)
            { PHASE_IDS(); pg8::GridOrder S; S.init(M, N_IN1, G, bx, XN, D * 2, WIN1, D * 2); EpiRowScale<2> E{PROJ, N_IN1, RSTD, COS, SIN};
              pg8::gemm_phase<EpiRowScale<2>, pg8::GridOrder>(lds + RING_OFF, tid, D * 2, D * 2, D / 64, S, E); }
            GRID_BAR();
            {
              for (int i0 = 0; ; ++i0) {
                  PHASE_IDS(); if (i0 * G + vcu >= 256) break;
                  XOrder S; S.G = G; S.c = vcu; S.i0 = i0; S.one = true; S.A = (const char*)PROJ + (size_t)xq_off * 2; S.lda = (size_t)ldp * 2; S.a_hoff = XA_HD * 2;
                  S.B = (const char*)(MEMK + (size_t)layer * 512 * 1024); S.b_boff = (size_t)256 * 1024 * 2; S.b_hoff = XA_HD * 2;
                  EpiXS E{PM};
                  pg8::gemm_phase<EpiXS, XOrder>(lds + RING_OFF, tid, (unsigned)(ldp * 2), 2048u, 4, S, E); }
              VM_WAIT(); __syncthreads(); }
            for (int rep = 0; rep < DUP_SWA; ++rep)
            {
                PHASE_IDS();
                constexpr int NCH = SEQ / 32, NUNITS = BATCH * NKVH * NCH;
                auto ref = [&](int U) { const int g = U / NCH, c = U - g * NCH; const int b = g / NKVH, kvh = g - b * NKVH; const size_t row0 = (size_t)b * SEQ + (size_t)c * 32;
                    swa::BlockRef<swa::bf16, swa::bf16> R; const bf16* base = PROJ + (size_t)(b * SEQ) * N_IN1;
                    R.Q = PROJ + row0 * N_IN1 + kvh * 8 * HD; R.K = base + SELF_W + kvh * HD; R.V = R.K + KV_W; R.O = Y + row0 * D + kvh * 8 * HD; R.P0 = c * 32; R.sink = attn_sink + kvh * 8; return R; };
                const int per = (NUNITS + G - 1) / G; int U = vcu * per; const int Uend = (U + per < NUNITS) ? U + per : NUNITS;
                if (U < Uend) {
                    swa::BlockRef<swa::bf16, swa::bf16> cur = ref(U);
                    swa::Seam<swa::bf16> S;
                    swa::causal_swa_prime<swa::bf16, swa::bf16>(cur, WINDOW, (char*)lds_raw + RING_OFF, S, tid);
                    for (;;) {
                        const bool last = (U + 1 >= Uend);
                        const swa::BlockRef<swa::bf16, swa::bf16> nxt = last ? cur : ref(U + 1);
                        swa::causal_swa_block<swa::bf16, swa::bf16>(cur, nxt, SEQ, WINDOW, (char*)lds_raw + RING_OFF, S, tid);
                        if (last) break;
                        cur = nxt; ++U;
                    }
                }
            }
            { PHASE_IDS();
              XOrder S; S.G = G; S.c = vcu; S.i0 = 0; S.one = false; S.A = (const char*)PM; S.lda = XA_W * 2; S.a_hoff = XA_HD * 2;
              S.B = (const char*)(VT + (size_t)layer * 1024 * 512); S.b_boff = 256 * 2; S.b_hoff = (size_t)XA_HD * 512 * 2;
              EpiXV E{Y};
              pg8::gemm_phase<EpiXV, XOrder>(lds + RING_OFF, tid, XA_W * 2, 1024u, 4, S, E); }
        }
        GRID_BAR();
        { PHASE_IDS(); pg8::GridOrder S; S.init(M, D, G, bx, Y, D * 2, layer == 0 ? WOUT0 : WOUT1, D * 2);
          EpiResid<false, false> E{XN, XN, SSQP}; pg8::gemm_phase<EpiResid<false, false>, pg8::GridOrder>(lds + RING_OFF, tid, D * 2, D * 2, D / 64, S, E); }
        LOCAL_BAR();
        { PHASE_IDS();
          if (G == 256) { if (tid < 64) { const int r = (bx & 7) * 2048 + (bx >> 3) * 64 + tid; const f32x4* p = (const f32x4*)(SSQP + (size_t)r * 64); float s = 0.f;
#pragma unroll
              for (int j = 0; j < 16; ++j) { const f32x4 v = p[j]; s += (v.x + v.y) + (v.z + v.w); }
              RSTD[r] = 1.0f / sqrtf(s * (1.f / D) + EPS); } }
          else { for (int r = vcu * 512 + tid; r < M; r += G * 512) { const f32x4* p = (const f32x4*)(SSQP + (size_t)r * 64); float s = 0.f;
#pragma unroll
              for (int j = 0; j < 16; ++j) { const f32x4 v = p[j]; s += (v.x + v.y) + (v.z + v.w); }
              RSTD[r] = 1.0f / sqrtf(s * (1.f / D) + EPS); } } }
        LOCAL_BAR();
        { PHASE_TID(); const int bxs = __builtin_amdgcn_readfirstlane((int)MISC[12]); const int dl = ((bxs >> 3) & 3) * 2; for (int i = 0; i < dl; ++i) __builtin_amdgcn_s_sleep(32); }
        for (int rep = 0; rep < DUP_UP; ++rep)
        { PHASE_IDS(); pg8::GridOrder S; S.init(M, FF, G, bx, XN, D * 2, W1T + (size_t)layer * FF * D, D * 2); EpiRowScale<1> E{HID, FF, RSTD, nullptr, nullptr};
          pg8::gemm_phase<EpiRowScale<1>, pg8::GridOrder>(lds + RING_OFF, tid, D * 2, D * 2, D / 64, S, E); }
        LOCAL_BAR();
        { PHASE_IDS(); pg8::GridOrder S; S.init(M, D, G, bx, HID, FF * 2, W2T + (size_t)layer * D * FF, FF * 2);
          EpiResid<false, false> E{XN, XN, SSQP}; pg8::gemm_phase<EpiResid<false, false>, pg8::GridOrder>(lds + RING_OFF, tid, FF * 2, FF * 2, FF / 64, S, E); }
        if (layer == 0) {
            LOCAL_BAR();
            { PHASE_IDS();
          if (G == 256) { if (tid < 64) { const int r = (bx & 7) * 2048 + (bx >> 3) * 64 + tid; const f32x4* p = (const f32x4*)(SSQP + (size_t)r * 64); float s = 0.f;
#pragma unroll
              for (int j = 0; j < 16; ++j) { const f32x4 v = p[j]; s += (v.x + v.y) + (v.z + v.w); }
              RSTD[r] = 1.0f / sqrtf(s * (1.f / D) + EPS); } }
          else { for (int r = vcu * 512 + tid; r < M; r += G * 512) { const f32x4* p = (const f32x4*)(SSQP + (size_t)r * 64); float s = 0.f;
#pragma unroll
              for (int j = 0; j < 16; ++j) { const f32x4 v = p[j]; s += (v.x + v.y) + (v.z + v.w); }
              RSTD[r] = 1.0f / sqrtf(s * (1.f / D) + EPS); } } }
            LOCAL_BAR();
        } else { GRID_BAR(); }
    }
    {
        PHASE_IDS();
        const bool poison = (__hip_atomic_load(ctl + CW_BAR + XB_TMO, RLX_AGENT) != 0u);
        const int gw = vcu * NWAVES + wave, NGW = G * NWAVES;
        for (int m = gw; m < M; m += NGW) {
            const GAS v4u* xr = (const GAS v4u*)(XN + (size_t)m * D) + lane; GAS f32x4* orow = (GAS f32x4*)(out + (size_t)m * D);
            v4u q[8]; float s = 0.f;
#pragma unroll
            for (int j = 0; j < 8; ++j) { q[j] = xr[64 * j]; const float a0 = bflo(q[j].x), a1 = bfhi(q[j].x), a2 = bflo(q[j].y), a3 = bfhi(q[j].y), a4 = bflo(q[j].z), a5 = bfhi(q[j].z), a6 = bflo(q[j].w), a7 = bfhi(q[j].w);
                s += ((a0 * a0 + a1 * a1) + (a2 * a2 + a3 * a3)) + ((a4 * a4 + a5 * a5) + (a6 * a6 + a7 * a7)); }
            float rstd = 1.0f / sqrtf(wave_sum(s) * (1.f / D) + EPS); if (poison) rstd = __builtin_nanf("");
#pragma unroll
            for (int j = 0; j < 8; ++j) { const int c = (64 * j + lane) * 8; const f32x4 g0 = *(const GAS f32x4*)(final_norm + c), g1 = *(const GAS f32x4*)(final_norm + c + 4);
                orow[(c >> 2)] = (f32x4){bflo(q[j].x) * rstd * g0.x, bfhi(q[j].x) * rstd * g0.y, bflo(q[j].y) * rstd * g0.z, bfhi(q[j].y) * rstd * g0.w};
                orow[(c >> 2) + 1] = (f32x4){bflo(q[j].z) * rstd * g1.x, bfhi(q[j].z) * rstd * g1.y, bflo(q[j].w) * rstd * g1.z, bfhi(q[j].w) * rstd * g1.w}; }
        }
    }
}

extern "C" void kernel_launch(void* const* d_in, const int* in_sizes, int n_in, void* d_out, int out_size, void* d_ws, size_t ws_size, hipStream_t stream) {
    static int grid = 0;
    if (grid == 0) {
        if (n_in != 17 || in_sizes[0] != M * D || out_size != M * D || ws_size < WS_END) { fprintf(stderr, "kernel_launch: unexpected shapes (n_in %d, in0 %d, out %d, ws %zu; need ws >= %zu); nothing launched\n", n_in, n_in > 0 ? in_sizes[0] : -1, out_size, ws_size, (size_t)WS_END); grid = -1; return; }
        int dev = 0, cus = 0, per_cu = 0;
        if (hipGetDevice(&dev) != hipSuccess || hipDeviceGetAttribute(&cus, hipDeviceAttributeMultiprocessorCount, dev) != hipSuccess) { fprintf(stderr, "kernel_launch: device query failed\n"); grid = -1; return; }
        if (hipFuncSetAttribute((const void*)fwd_kernel, hipFuncAttributeMaxDynamicSharedMemorySize, LDS_BYTES) != hipSuccess) { fprintf(stderr, "kernel_launch: hipFuncSetAttribute failed\n"); grid = -1; return; }
        if (hipOccupancyMaxActiveBlocksPerMultiprocessor(&per_cu, (const void*)fwd_kernel, NWAVES * 64, LDS_BYTES) != hipSuccess || per_cu < 1)
            fprintf(stderr, "kernel_launch: note: occupancy query reports %d workgroups per CU\n", per_cu);
        (void)hipGetLastError();
        grid = cus;
    }
    if (grid < 0) return;
    if (hipMemsetAsync((char*)d_ws + WS_CTL, 0, CTL_ZERO_BYTES, stream) != hipSuccess) { fprintf(stderr, "kernel_launch: memset failed\n"); return; }
    Args a{};
    for (int i = 0; i < 17; ++i) a.in[i] = d_in[i];
    a.out = (float*)d_out; a.ws = (unsigned char*)d_ws;
    hipLaunchKernelGGL(fwd_kernel, dim3(grid), dim3(NWAVES * 64), LDS_BYTES, stream, a);
    const hipError_t le = hipPeekAtLastError();
    if (le != hipSuccess) fprintf(stderr, "kernel_launch: launch failed: %s\n", hipGetErrorName(le));
}
```

```cpp
#include <hip/hip_runtime.h>
#include <cstdio>
#include <cstdint>

#define SWZ_XOR(v, k) __builtin_bit_cast(float, __builtin_amdgcn_ds_swizzle(__builtin_bit_cast(int, (float)(v)), (((k) << 10) | 0x1f)))
__device__ __forceinline__ float xor16_add(float v) { return v + SWZ_XOR(v, 16); }
__device__ __forceinline__ float xor16_max(float v) { return fmaxf(v, SWZ_XOR(v, 16)); }
__device__ __forceinline__ float xor32_add(float v) { auto r = __builtin_amdgcn_permlane32_swap(__float_as_uint(v), __float_as_uint(v), false, false); const unsigned a = r[0], b = r[1]; return __uint_as_float(a) + __uint_as_float(b); }
__device__ __forceinline__ float xor32_max(float v) { auto r = __builtin_amdgcn_permlane32_swap(__float_as_uint(v), __float_as_uint(v), false, false); const unsigned a = r[0], b = r[1]; return fmaxf(__uint_as_float(a), __uint_as_float(b)); }
__device__ __forceinline__ float xor32_other(float v, bool lo_half) { auto r = __builtin_amdgcn_permlane32_swap(__float_as_uint(v), __float_as_uint(v), false, false); const unsigned a = r[0], b = r[1]; return __uint_as_float(lo_half ? b : a); }
__device__ __forceinline__ float dpp_xor1(float v) { return __builtin_bit_cast(float, __builtin_amdgcn_mov_dpp(__builtin_bit_cast(int, v), 0xB1, 0xF, 0xF, true)); }

namespace pg8 {
#define PG8_LAS __attribute__((address_space(3)))
typedef unsigned short bf16_t;
typedef short bf16x8 __attribute__((ext_vector_type(8)));
typedef float f32x4 __attribute__((ext_vector_type(4)));
typedef unsigned u32x4 __attribute__((ext_vector_type(4)));
typedef unsigned u32x2 __attribute__((ext_vector_type(2)));
constexpr int BM = 256, BK = 64, HALF = 128, HTB = HALF * BK * 2  , STAGE_BYTES = 8 * HTB, NXCD = 8, WGM = 8;

__host__ __device__ __forceinline__ int lds_byte(int r, int c) { const int st = (r >> 4) * 2 + (c >> 5), rr = r & 15, cc = c & 31, ob = rr * 64 + cc * 2; return st * 1024 + (ob ^ (((ob >> 9) & 1) << 5)); }
__host__ __device__ __forceinline__ void stage_rc(int b, int& R, int& C) { const int st = b / 1024, sb = b % 1024, swz = sb ^ (((sb >> 9) & 1) << 5); R = (st >> 1) * 16 + swz / 64; C = (st & 1) * 32 + (swz % 64) / 2; }
__host__ __device__ __forceinline__ int perm32(int rho) { const int n = rho >> 4, i = rho & 15; return 8 * (i >> 2) + 4 * n + (i & 3); }

struct Unit { int pm, pn, z; const char* a; const char* b; };

struct GridOrder {
    int nM, nN, nwg, G, c; const char* A; const char* B; size_t ta, tb;
    __device__ __forceinline__ void init(int M, int N, int G_, int c_, const void* A_, size_t lda, const void* B_, size_t ldb) { nM = M / BM; nN = N / BM; nwg = nM * nN; G = G_; c = c_; A = (const char*)A_; B = (const char*)B_; ta = lda * BM; tb = ldb * BM; }
    __device__ __forceinline__ bool next(int i, Unit& u) const {
        const long L = (long)i * G + c; if (L >= nwg) return false;
        int wgid = (int)L; { const int q = nwg / NXCD, r = nwg % NXCD, xcd = wgid % NXCD, off = wgid / NXCD; wgid = (xcd < r ? xcd * (q + 1) : r * (q + 1) + (xcd - r) * q) + off; }
        const int nig = WGM * nN, gid = wgid / nig, fm = gid * WGM, gsz = (nM - fm) < WGM ? (nM - fm) : WGM;
        u.pm = fm + ((wgid % nig) % gsz); u.pn = (wgid % nig) / gsz; u.z = 0; u.a = A + (size_t)u.pm * ta; u.b = B + (size_t)u.pn * tb; return true;
    }
};

__device__ __forceinline__ unsigned cvt_pk_bf16(float lo, float hi) { unsigned r; asm volatile("v_cvt_pk_bf16_f32 %0, %1, %2" : "=v"(r) : "v"(lo), "v"(hi)); return r; }
__device__ __forceinline__ void st_bf16x8(bf16_t* p, f32x4 v0, f32x4 v1) { u32x4 w; w.x = cvt_pk_bf16(v0[0], v0[1]); w.y = cvt_pk_bf16(v0[2], v0[3]); w.z = cvt_pk_bf16(v1[0], v1[1]); w.w = cvt_pk_bf16(v1[2], v1[3]); *(u32x4*)p = w; }


template <class Epi, class Sched>
__device__ __forceinline__ void gemm_phase(PG8_LAS unsigned char* lds, const int tid  , const unsigned lda, const unsigned ldb, const int nt, const Sched& S, const Epi& E) {
    constexpr bool ALIGN_EPI = true;
    const int wid = __builtin_amdgcn_readfirstlane(tid >> 6), lane = tid & 63, wr = wid >> 2, wc = wid & 3, fr = lane & 15, fq = lane >> 4;
    unsigned voffA[2], voffB[2];
#pragma unroll
    for (int i = 0; i < 2; ++i) { int R, C; stage_rc(tid * 16 + i * 8192, R, C); const int Rb = (R & ~31) + perm32(R & 31);
        voffA[i] = (unsigned)R * lda + (unsigned)C * 2u; voffB[i] = (unsigned)Rb * ldb + (unsigned)C * 2u; }
    const size_t kstep = (size_t)(BK * 2);
    const size_t hstepA = (size_t)HALF * lda, hstepB = (size_t)HALF * ldb;
    const unsigned ldsw = (unsigned)wid * 1024u;
    const int aoff = lds_byte(wr * 64 + fr, fq * 8), boff = lds_byte(wc * 32 + fr, fq * 8);
#define PG8_SA(b, h) (((b) * 2 + (h)) * HTB)
#define PG8_SB(b, h) ((4 + (b) * 2 + (h)) * HTB)
#define PG8_STAGE(bufoff, gbase, voff) do { _Pragma("unroll") for (int _i = 0; _i < 2; ++_i) \
        __builtin_amdgcn_global_load_lds((const unsigned*)((const char*)(gbase) + (voff)[_i]), (PG8_LAS unsigned*)(lds + (bufoff) + ldsw + _i * 8192), 16, 0, 0); } while (0)
#define PG8_LDA(dst, b, h) do { _Pragma("unroll") for (int m = 0; m < 4; ++m) _Pragma("unroll") for (int k = 0; k < 2; ++k) dst[m][k] = *(const PG8_LAS bf16x8*)(lds + PG8_SA(b, h) + aoff + m * 2048 + k * 1024); } while (0)
#define PG8_LDB(dst, b, h) do { _Pragma("unroll") for (int n = 0; n < 2; ++n) _Pragma("unroll") for (int k = 0; k < 2; ++k) dst[n][k] = *(const PG8_LAS bf16x8*)(lds + PG8_SB(b, h) + boff + n * 2048 + k * 1024); } while (0)
#define PG8_MMA(ai, bj, At, Bt) do { __builtin_amdgcn_s_setprio(1); _Pragma("unroll") for (int m = 0; m < 4; ++m) _Pragma("unroll") for (int n = 0; n < 2; ++n) _Pragma("unroll") for (int k = 0; k < 2; ++k) \
        acc[ai][bj][m][n] = __builtin_amdgcn_mfma_f32_16x16x32_bf16(Bt[n][k], At[m][k], acc[ai][bj][m][n], 0, 0, 0); __builtin_amdgcn_s_setprio(0); } while (0)
#define PG8_WAIT_V(n) asm volatile("s_waitcnt vmcnt(" #n ")" ::: "memory")
#define PG8_WAIT_L(n) asm volatile("s_waitcnt lgkmcnt(" #n ")" ::: "memory")
#define PG8_BAR __builtin_amdgcn_s_barrier()
#define PG8_SCHED __builtin_amdgcn_sched_barrier(0)
    Unit cur, nxt; int ui = 0;
    if (!S.next(0, cur)) return;
    f32x4 acc[2][2][4][2];
#pragma unroll
    for (int a = 0; a < 2; ++a)
#pragma unroll
        for (int b = 0; b < 2; ++b)
#pragma unroll
            for (int m = 0; m < 4; ++m)
#pragma unroll
                for (int n = 0; n < 2; ++n) acc[a][b][m][n] = (f32x4){0.f, 0.f, 0.f, 0.f};
    bf16x8 At[4][2], B0[2][2], B1[2][2];
    const char* cA = cur.a; const char* cB = cur.b;
    PG8_STAGE(PG8_SB(0, 0), cB, voffB); PG8_STAGE(PG8_SB(0, 1), cB + hstepB, voffB); PG8_STAGE(PG8_SA(0, 0), cA, voffA); PG8_STAGE(PG8_SA(0, 1), cA + hstepA, voffA);
    if (wr == 1) PG8_BAR;
    PG8_WAIT_V(2); PG8_BAR;
    PG8_STAGE(PG8_SB(1, 0), cB + kstep, voffB); PG8_STAGE(PG8_SA(1, 0), cA + kstep, voffA); PG8_STAGE(PG8_SB(1, 1), cB + hstepB + kstep, voffB);
    PG8_WAIT_V(6); PG8_BAR;
    for (;;) {
        const bool has_next = S.next(ui + 1, nxt);
        const char* nA = has_next ? nxt.a : cA; const char* nB = has_next ? nxt.b : cB;
        for (int t = 0; t < nt; t += 2) {
            const bool last = (t == nt - 2);
            const char* a1 = cA + (size_t)(t + 1) * kstep;
            const char* a2 = last ? nA : cA + (size_t)(t + 2) * kstep; const char* b2 = last ? nB : cB + (size_t)(t + 2) * kstep;
            const char* a3 = a2 + kstep; const char* b3 = b2 + kstep;
            PG8_LDB(B0, 0, 0); PG8_LDB(B1, 0, 1); PG8_SCHED; PG8_LDA(At, 0, 0); PG8_STAGE(PG8_SA(1, 1), a1 + hstepA, voffA);
            PG8_WAIT_V(8); PG8_WAIT_L(0); PG8_BAR; PG8_MMA(0, 0, At, B0); PG8_MMA(0, 1, At, B1); PG8_BAR; PG8_SCHED;
            PG8_LDA(At, 0, 1); PG8_STAGE(PG8_SB(0, 0), b2, voffB); PG8_STAGE(PG8_SB(0, 1), b2 + hstepB, voffB); PG8_STAGE(PG8_SA(0, 0), a2, voffA);
            PG8_WAIT_V(8); PG8_WAIT_L(0); PG8_BAR; PG8_MMA(1, 0, At, B0); PG8_MMA(1, 1, At, B1); PG8_BAR; PG8_SCHED;
            PG8_LDB(B0, 1, 0); PG8_LDB(B1, 1, 1); PG8_SCHED; PG8_LDA(At, 1, 0); PG8_STAGE(PG8_SA(0, 1), a2 + hstepA, voffA);
            PG8_WAIT_V(8); PG8_WAIT_L(0); PG8_BAR; PG8_MMA(0, 0, At, B0); PG8_MMA(0, 1, At, B1); PG8_BAR; PG8_SCHED;
            PG8_LDA(At, 1, 1); PG8_STAGE(PG8_SB(1, 0), b3, voffB); PG8_STAGE(PG8_SB(1, 1), b3 + hstepB, voffB); PG8_STAGE(PG8_SA(1, 0), a3, voffA);
            PG8_WAIT_V(8); PG8_WAIT_L(0); PG8_BAR; PG8_MMA(1, 0, At, B0); PG8_MMA(1, 1, At, B1); PG8_BAR; PG8_SCHED;
        }
        if constexpr (ALIGN_EPI) { if (wr == 0) PG8_BAR; }
        if constexpr (!Epi::AFTER_DRAIN) {
            int l2; asm volatile("v_mbcnt_lo_u32_b32 %0, -1, 0\n\tv_mbcnt_hi_u32_b32 %0, -1, %0" : "=v"(l2));
            E(acc, cur, wr, wc, l2 & 15, l2 >> 4); }
        if (!has_next) break;
#pragma unroll
        for (int a = 0; a < 2; ++a)
#pragma unroll
            for (int b = 0; b < 2; ++b)
#pragma unroll
                for (int m = 0; m < 4; ++m)
#pragma unroll
                    for (int n = 0; n < 2; ++n) acc[a][b][m][n] = (f32x4){0.f, 0.f, 0.f, 0.f};
        cur = nxt; cA = nA; cB = nB; ++ui;
        if constexpr (ALIGN_EPI) { if (wr == 1) PG8_BAR; }
    }
    PG8_WAIT_V(0);
    if constexpr (!ALIGN_EPI) { if (wr == 0) PG8_BAR; }
    PG8_BAR;
    if constexpr (Epi::AFTER_DRAIN) { int l2; asm volatile("v_mbcnt_lo_u32_b32 %0, -1, 0\n\tv_mbcnt_hi_u32_b32 %0, -1, %0" : "=v"(l2)); E.fused(acc, cur, wr, wc, l2 & 15, l2 >> 4, lds, wid, l2); }
#undef PG8_SA
#undef PG8_SB
#undef PG8_STAGE
#undef PG8_LDA
#undef PG8_LDB
#undef PG8_MMA
#undef PG8_WAIT_V
#undef PG8_WAIT_L
#undef PG8_BAR
#undef PG8_SCHED
}
}

namespace swa {
typedef unsigned short bf16;
typedef short bf16x8 __attribute__((ext_vector_type(8)));
typedef short s16x4 __attribute__((ext_vector_type(4)));
typedef float f32x16 __attribute__((ext_vector_type(16)));
typedef float f32x4 __attribute__((ext_vector_type(4)));
typedef unsigned u32x4 __attribute__((ext_vector_type(4)));
template <class A, class Bt> struct same_t { static constexpr bool v = false; };
template <class A> struct same_t<A, A> { static constexpr bool v = true; };
constexpr int D = 128;
constexpr int QP = 4864, OP = 4096;
constexpr int WINDOW = 128; constexpr float THR = 8.f; constexpr bool WSKIP = false;
constexpr float SCALE = 0.08838834764831845f;
constexpr int NW = 8, QBLK = 32, KVBLK = 64, QB = NW * QBLK;
constexpr int SHM_V = KVBLK * D * 2, SHM_K = KVBLK * D * 2;
constexpr int LDS_BYTES = 2 * SHM_V + 2 * SHM_K + NW * 64 * 4;
#define KSWZ(row, colB) ((row) * 256 + ((colB) ^ (((row) & 7) << 4)))
#define SBAR() __builtin_amdgcn_sched_barrier(0)
__device__ __forceinline__ int v_st(int k, int c) { const int kk = (k & ~0xC) | ((k & 4) << 1) | ((k & 8) >> 1); return ((kk >> 3) * 4 + (c >> 5)) * 512 + ((kk & 7) * 32 + (c & 31)) * 2; }
__device__ __forceinline__ int v_rd_base(int lane) { return ((lane & 3) << 3) | (((lane >> 2) & 3) << 6) | (((lane >> 4) & 1) << 5) | (((lane >> 5) & 1) << 8); }
constexpr int v_rd_off(int d0, int ks, int half) { return d0 * 512 + ks * 4096 + half * 2048; }
__device__ __forceinline__ int crow(int r, int hi) { return (r & 3) + 8 * (r >> 2) + 4 * hi; }
__device__ __forceinline__ unsigned cvtpk(float lo, float hi) {
    unsigned r; asm volatile("v_cvt_pk_bf16_f32 %0, %1, %2" : "=v"(r) : "v"(lo), "v"(hi)); return r;
}
__device__ __forceinline__ bf16x8 pack8(f32x4 a, f32x4 b) {
    u32x4 w = {cvtpk(a[0], a[1]), cvtpk(a[2], a[3]), cvtpk(b[0], b[1]), cvtpk(b[2], b[3])};
    return *reinterpret_cast<bf16x8*>(&w);
}
template <class T> __device__ __forceinline__ bf16x8 load8(const T* p) {
    if constexpr (same_t<T, float>::v) { return pack8(*(const f32x4*)p, *(const f32x4*)(p + 4)); }
    else { return *reinterpret_cast<const bf16x8*>(p); }
}
__device__ __forceinline__ void mask_tile(f32x16& p0, f32x16& p1, int dq, unsigned W) {
    const float NEG = -__builtin_inff();
#pragma unroll
    for (int r = 0; r < 16; ++r) {
        const int c = (r & 3) + 8 * (r >> 2);
        if ((unsigned)(dq - c) >= W) p0[r] = NEG;
        if ((unsigned)(dq - c - 32) >= W) p1[r] = NEG;
    }
}
__device__ __forceinline__ void partialSM(f32x16& p0, f32x16& p1, float& m_reg, float& mn, float& alpha) {
    float pmax = p0[0]; for (int r = 1; r < 16; ++r) pmax = fmaxf(pmax, p0[r]); for (int r = 0; r < 16; ++r) pmax = fmaxf(pmax, p1[r]);
    { auto rr = __builtin_amdgcn_permlane32_swap(__float_as_uint(pmax), __float_as_uint(pmax), false, false);
      pmax = fmaxf(__uint_as_float(rr[0]), __uint_as_float(rr[1])); }
    constexpr float C2 = 1.4426950408889634f * SCALE;
    if (__builtin_expect(__all((pmax - m_reg) * SCALE <= THR), 1)) { mn = m_reg; alpha = 1.f; }
    else { mn = fmaxf(m_reg, pmax); alpha = __builtin_amdgcn_exp2f((m_reg - mn) * C2); m_reg = mn; }
    const float mnL = -mn * C2;
    for (int r = 0; r < 16; ++r) p0[r] = fmaf(p0[r], C2, mnL); for (int r = 0; r < 16; ++r) p1[r] = fmaf(p1[r], C2, mnL);
    for (int r = 0; r < 16; ++r) p0[r] = __builtin_amdgcn_exp2f(p0[r]);
}
__device__ __forceinline__ void finishSM(f32x16& p0, f32x16& p1, float alpha, float& l_reg, bf16x8& pa0, bf16x8& pa1, bf16x8& pa2, bf16x8& pa3) {
    for (int r = 0; r < 16; ++r) p1[r] = __builtin_amdgcn_exp2f(p1[r]);
    float ps = 0; for (int r = 0; r < 16; ++r) ps += p0[r]; for (int r = 0; r < 16; ++r) ps += p1[r];
    { auto rr = __builtin_amdgcn_permlane32_swap(__float_as_uint(ps), __float_as_uint(ps), false, false);
      ps = __uint_as_float(rr[0]) + __uint_as_float(rr[1]); }
    l_reg = l_reg * alpha + ps;
#define PK4(P, B_, OUT) do { unsigned a0 = cvtpk(P[B_+0], P[B_+1]), a1 = cvtpk(P[B_+2], P[B_+3]);                          \
        unsigned b0 = cvtpk(P[B_+4], P[B_+5]), b1 = cvtpk(P[B_+6], P[B_+7]);                                             \
        auto r0 = __builtin_amdgcn_permlane32_swap(a0, b0, false, false); auto r1 = __builtin_amdgcn_permlane32_swap(a1, b1, false, false); \
        u32x4 w = {r0[0], r1[0], r0[1], r1[1]}; OUT = *reinterpret_cast<bf16x8*>(&w); } while (0)
    PK4(p0, 0, pa0); PK4(p0, 8, pa1); PK4(p1, 0, pa2); PK4(p1, 8, pa3);
#undef PK4
}
template <int KB, bool SK>
__device__ __forceinline__ void qkt(f32x16& p0, f32x16& p1, const char* K_lds, int r32, int hi, const bf16x8* qr, bool act) {
    if (SK && !act) { const float NEG = -__builtin_inff();
#pragma unroll
        for (int r = 0; r < 16; ++r) { p0[r] = NEG; p1[r] = NEG; } return; }
    p0 = f32x16{}; p1 = f32x16{};
    const char* kb[4];
#pragma unroll
    for (int dd = 0; dd < 4; ++dd) kb[dd] = K_lds + KB * SHM_K + KSWZ(r32, (dd * 16 + hi * 8) * 2);
#pragma unroll
    for (int d0 = 0; d0 < 8; ++d0) { const char* a = kb[d0 & 3] + (d0 >> 2) * 128;
        bf16x8 b0 = *reinterpret_cast<const bf16x8*>(a);
        bf16x8 b1 = *reinterpret_cast<const bf16x8*>(a + 32 * 256);
        p0 = __builtin_amdgcn_mfma_f32_32x32x16_bf16(b0, qr[d0], p0, 0, 0, 0);
        p1 = __builtin_amdgcn_mfma_f32_32x32x16_bf16(b1, qr[d0], p1, 0, 0, 0); }
}
template <int VB, bool SK>
__device__ __forceinline__ void pv_tile(f32x16* o, int vb0, bf16x8 pa0, bf16x8 pa1, bf16x8 pa2, bf16x8 pa3, bool act) {
    if (SK && !act) return;
#define TRRD(dst, off) asm volatile("ds_read_b64_tr_b16 %0, %1 offset:%2" : "=&v"(dst) : "v"(vb0), "i"(off) : "memory")
#define PV_D0(d0) do { s16x4 l0, l1, l2, l3, h0, h1, h2, h3; constexpr int b_ = VB * SHM_V + v_rd_off(d0, 0, 0);     \
        TRRD(l0, b_); TRRD(h0, b_ + 2048); TRRD(l1, b_ + 4096); TRRD(h1, b_ + 6144); TRRD(l2, b_ + 8192); TRRD(h2, b_ + 10240); TRRD(l3, b_ + 12288); TRRD(h3, b_ + 14336); \
        asm volatile("s_waitcnt lgkmcnt(0)" ::: "memory"); SBAR();                 \
        o[d0] = __builtin_amdgcn_mfma_f32_32x32x16_bf16(pa0, (bf16x8){l0[0], l0[1], l0[2], l0[3], h0[0], h0[1], h0[2], h0[3]}, o[d0], 0, 0, 0);   \
        o[d0] = __builtin_amdgcn_mfma_f32_32x32x16_bf16(pa1, (bf16x8){l1[0], l1[1], l1[2], l1[3], h1[0], h1[1], h1[2], h1[3]}, o[d0], 0, 0, 0);   \
        o[d0] = __builtin_amdgcn_mfma_f32_32x32x16_bf16(pa2, (bf16x8){l2[0], l2[1], l2[2], l2[3], h2[0], h2[1], h2[2], h2[3]}, o[d0], 0, 0, 0);   \
        o[d0] = __builtin_amdgcn_mfma_f32_32x32x16_bf16(pa3, (bf16x8){l3[0], l3[1], l3[2], l3[3], h3[0], h3[1], h3[2], h3[3]}, o[d0], 0, 0, 0); } while (0)
    PV_D0(0); PV_D0(1); PV_D0(2); PV_D0(3);
#undef PV_D0
#undef TRRD
}

template <class TIn, class TOut> struct BlockRef { const TIn* Q; const TIn* K; const TIn* V; TOut* O; int P0; const float* sink; };
template <class TIn> struct Seam {
    bf16x8 qr[8];
    bf16x8 st_v0, st_v1, st_k0, st_k1; f32x4 sf0, sf1, sf2, sf3;
    f32x4 tq[16];
};
__device__ __forceinline__ int swa_jlo(int P0, int W) { const int lowk = P0 - W + 1; return lowk > 0 ? lowk / KVBLK : 0; }
#define ROW(p, k0, rr) ((p) + (size_t)((k0) + (rr)) * QP + sc)
#define VMW() asm volatile("s_waitcnt vmcnt(0)" ::: "memory")
#define VMWN(n) asm volatile("s_waitcnt vmcnt(%0)" :: "i"(n) : "memory")
#define SLOAD_H(Kp, Vp, k0) do { S.st_v0 = load8<TIn>(ROW(Vp, k0, sr)); S.st_v1 = load8<TIn>(ROW(Vp, k0, 32 + sr));              \
                         S.st_k0 = load8<TIn>(ROW(Kp, k0, sr)); S.st_k1 = load8<TIn>(ROW(Kp, k0, 32 + sr)); } while (0)
#define SWRITE_HK(bf) do { *(bf16x8*)(K_lds + (bf) * SHM_K + kws) = S.st_k0; *(bf16x8*)(K_lds + (bf) * SHM_K + kws + 32 * 256) = S.st_k1; } while (0)
#define SWRITE_HV(bf) do { *(bf16x8*)(V_lds + (bf) * SHM_V + vst0) = S.st_v0; *(bf16x8*)(V_lds + (bf) * SHM_V + vst1) = S.st_v1; } while (0)
#define SWRITE_H(bf) do { SWRITE_HV(bf); SWRITE_HK(bf); } while (0)
#define SLOAD_F(p, k0) do { S.sf0 = *(const f32x4*)ROW(p, k0, sr); S.sf1 = *(const f32x4*)(ROW(p, k0, sr) + 4);                \
                            S.sf2 = *(const f32x4*)ROW(p, k0, 32 + sr); S.sf3 = *(const f32x4*)(ROW(p, k0, 32 + sr) + 4); } while (0)
#define SWRITE_KF(bf) do { *(bf16x8*)(K_lds + (bf) * SHM_K + kws) = pack8(S.sf0, S.sf1); *(bf16x8*)(K_lds + (bf) * SHM_K + kws + 32 * 256) = pack8(S.sf2, S.sf3); } while (0)
#define SWRITE_VF(bf) do { *(bf16x8*)(V_lds + (bf) * SHM_V + vst0) = pack8(S.sf0, S.sf1); *(bf16x8*)(V_lds + (bf) * SHM_V + vst1) = pack8(S.sf2, S.sf3); } while (0)
template <class TIn, class TOut>
__device__ __forceinline__ void causal_swa_prime(const BlockRef<TIn, TOut>& cur, int W, char* lds, Seam<TIn>& S, const int tid) {
    constexpr bool F32 = same_t<TIn, float>::v;
    const int wid = __builtin_amdgcn_readfirstlane(tid >> 6), lane = tid & 63, r32 = lane & 31, hi = lane >> 5;
    const int sr = tid >> 4, sc = (tid & 15) * 8, kws = KSWZ(sr, sc * 2); char* K_lds = lds + 2 * SHM_V;
    const int kb0 = swa_jlo(cur.P0, W) * KVBLK;
    for (int d0 = 0; d0 < 8; ++d0) S.qr[d0] = load8<TIn>(cur.Q + (size_t)r32 * QP + wid * D + d0 * 16 + hi * 8);
    if constexpr (F32) { SLOAD_F((const float*)cur.K, kb0); VMW(); SWRITE_KF(0); SBAR(); SLOAD_F((const float*)cur.V, kb0); }
    else { SLOAD_H(cur.K, cur.V, kb0); VMW(); SWRITE_HK(0); }
    __syncthreads();
}
template <class TIn, class TOut>
__device__ __forceinline__ void causal_swa_block(const BlockRef<TIn, TOut>& cur, const BlockRef<TIn, TOut>& nxt, int skv, int W, char* lds, Seam<TIn>& S, const int tid) {
    constexpr bool F32 = same_t<TIn, float>::v;
    const int wid = __builtin_amdgcn_readfirstlane(tid >> 6), lane = tid & 63, r32 = lane & 31, hi = lane >> 5;
    const int j_lo = swa_jlo(cur.P0, W);
    int j_hi = (cur.P0 + QBLK - 1) / KVBLK + 1; if (j_hi > skv / KVBLK) j_hi = skv / KVBLK;
    const int NT = j_hi - j_lo;
    const int kbn = swa_jlo(nxt.P0, W) * KVBLK;
    const int qlo = cur.P0, qm = qlo + r32 - 4 * hi;
    char* V_lds = lds; char* K_lds = lds + 2 * SHM_V;
    float* ws = (float*)(lds + 2 * SHM_V + 2 * SHM_K) + wid * 64; float* li_l = ws, * al_l = ws + 32;
    float m_reg = cur.sink[wid] * (1.0f / SCALE), l_reg = 1.0f; f32x16 o[4] = {};
    const int sr = tid >> 4, sc = (tid & 15) * 8, vst0 = v_st(sr, sc), vst1 = v_st(32 + sr, sc), kws = KSWZ(sr, sc * 2);
    const int vb0 = (int)(uintptr_t)V_lds + v_rd_base(lane);
    const TIn* Kh = cur.K; const TIn* Vh = cur.V;
#define RESC(a) do { if (__any((a) < 1.f)) { if (hi == 0) al_l[r32] = (a); asm volatile("s_waitcnt lgkmcnt(0)" ::: "memory");              \
                     for (int d_ = 0; d_ < 4; ++d_) for (int r = 0; r < 16; ++r) o[d_][r] *= al_l[crow(r, hi)]; } } while (0)
#define KBASE(t) ((j_lo + (t)) * KVBLK)
#define ACT(t) (KBASE(t) <= qlo + QBLK - 1 && KBASE(t) + KVBLK - 1 >= qlo - W + 1)
#define MASKT(P0_, P1_, t) do { const int kb_ = KBASE(t); if ((!SK || ACT(t)) && (kb_ + KVBLK - 1 > qlo || kb_ <= qlo + QBLK - 1 - W)) mask_tile(P0_, P1_, qm - kb_, (unsigned)W); } while (0)
    constexpr int NQL = F32 ? 16 : 8;
    constexpr bool SK = WSKIP && !F32;
#define SEAM_K0() do { VMWN(NQL); if constexpr (F32) { SWRITE_KF(0); SBAR(); SLOAD_F((const float*)nxt.V, kbn); } else { SWRITE_HK(0); } SBAR(); } while (0)
    f32x16 pA0, pA1, pB0, pB1; float mnA, mnB, alA, alB; bf16x8 pa0, pa1, pa2, pa3;
    if constexpr (F32) { VMW(); SWRITE_VF(0); SBAR(); } else { SWRITE_HV(0); SBAR(); }
    if (NT > 1) { if constexpr (F32) SLOAD_F((const float*)Kh, KBASE(1)); else SLOAD_H(Kh, Vh, KBASE(1)); }
    SBAR(); qkt<0, SK>(pA0, pA1, K_lds, r32, hi, S.qr, ACT(0));
    if constexpr (F32) { if (NT > 1) { VMW(); SWRITE_KF(1); SBAR(); SLOAD_F((const float*)Vh, KBASE(1)); } }
    MASKT(pA0, pA1, 0); partialSM(pA0, pA1, m_reg, mnA, alA);
    if (NT > 1) { VMW(); if constexpr (F32) { SWRITE_VF(1); SBAR(); if (NT > 2) SLOAD_F((const float*)Kh, KBASE(2)); } else SWRITE_H(1); }
    __syncthreads();
#define HALF_STEP(PX0, PX1, mnX, alX, PY0, PY1, alY, t, KB, VB, SB) do {                                                      \
        SBAR(); qkt<KB, SK>(PX0, PX1, K_lds, r32, hi, S.qr, ACT(t));                                             \
        finishSM(PY0, PY1, alY, l_reg, pa0, pa1, pa2, pa3); SBAR();                                                           \
        if ((t) + 1 < NT) { if constexpr (F32) { VMW(); SWRITE_KF(SB); SBAR(); SLOAD_F((const float*)Vh, KBASE((t) + 1)); }  \
                            else { SLOAD_H(Kh, Vh, KBASE((t) + 1)); } SBAR(); }                                               \
        pv_tile<VB, SK>(o, vb0, pa0, pa1, pa2, pa3, ACT((t) - 1)); MASKT(PX0, PX1, (t)); partialSM(PX0, PX1, m_reg, mnX, alX);                                        \
        __syncthreads();                                                                                                      \
        if ((t) + 1 < NT) { VMW(); if constexpr (F32) { SWRITE_VF(SB); SBAR(); if ((t) + 2 < NT) SLOAD_F((const float*)Kh, KBASE((t) + 2)); } \
                            else { SWRITE_H(SB); } }                                                                          \
        RESC(alX); __syncthreads(); } while (0)
    for (int t = 1; t + 1 < NT; t += 2) {
        HALF_STEP(pB0, pB1, mnB, alB, pA0, pA1, alA, t, 1, 0, 0);
        HALF_STEP(pA0, pA1, mnA, alA, pB0, pB1, alB, t + 1, 0, 1, 1);
    }
    const bool even = (NT & 1) == 0;
    if (even) { SBAR(); qkt<1, SK>(pB0, pB1, K_lds, r32, hi, S.qr, ACT(NT - 1)); SBAR(); }
#define QROW(e) (nxt.Q + (size_t)r32 * QP + wid * D + ((e) >> 1) * 16 + hi * 8 + ((e) & 1) * 4)
    if constexpr (F32) { SLOAD_F((const float*)nxt.K, kbn); SBAR();
#pragma unroll
        for (int e = 0; e < 8; ++e) S.tq[e] = *(const f32x4*)QROW(e); }
    else { SLOAD_H(nxt.K, nxt.V, kbn); SBAR();
#pragma unroll
        for (int d0 = 0; d0 < 8; ++d0) S.qr[d0] = load8<TIn>(nxt.Q + (size_t)r32 * QP + wid * D + d0 * 16 + hi * 8); }
    SBAR();
    finishSM(pA0, pA1, alA, l_reg, pa0, pa1, pa2, pa3); SBAR();
    if constexpr (F32) {
#pragma unroll
        for (int e = 8; e < 16; ++e) S.tq[e] = *(const f32x4*)QROW(e); SBAR(); }
#undef QROW
    pv_tile<0, SK>(o, vb0, pa0, pa1, pa2, pa3, ACT(even ? NT - 2 : NT - 1));
    if (even) { MASKT(pB0, pB1, NT - 1); partialSM(pB0, pB1, m_reg, mnB, alB); __syncthreads(); RESC(alB);
        finishSM(pB0, pB1, alB, l_reg, pa0, pa1, pa2, pa3); SBAR(); pv_tile<1, SK>(o, vb0, pa0, pa1, pa2, pa3, ACT(NT - 1)); }
    SBAR(); SEAM_K0();
    if (hi == 0) li_l[r32] = l_reg; asm volatile("s_waitcnt lgkmcnt(0)" ::: "memory");
    float rli[16];
#pragma unroll
    for (int r = 0; r < 16; ++r) rli[r] = __builtin_amdgcn_rcpf(li_l[crow(r, hi)]);
    TOut* Ow = cur.O + wid * D;
#pragma unroll
    for (int r = 0; r < 16; ++r) { const int orow = crow(r, hi);
#pragma unroll
        for (int d0 = 0; d0 < 4; ++d0) { const float v = o[d0][r] * rli[r];
            if constexpr (same_t<TOut, float>::v) { Ow[(size_t)orow * OP + d0 * 32 + r32] = v; }
            else { const float vn = dpp_xor1(v);
                   if ((r32 & 1) == 0) *(unsigned*)(Ow + (size_t)orow * OP + d0 * 32 + r32) = cvtpk(v, vn); } } }
    if constexpr (F32) {
#pragma unroll
        for (int d0 = 0; d0 < 8; ++d0) S.qr[d0] = pack8(S.tq[2 * d0], S.tq[2 * d0 + 1]); }
    __syncthreads();
#undef RESC
#undef KBASE
#undef ACT
#undef MASKT
#undef SEAM_K0
#undef HALF_STEP
}
#undef ROW
#undef VMW
#undef VMWN
#undef SLOAD_H
#undef SWRITE_HK
#undef SWRITE_HV
#undef SWRITE_H
#undef SLOAD_F
#undef SWRITE_KF
#undef SWRITE_VF
}

constexpr int NWAVES = 8;
constexpr int BATCH = 2, SEQ = 8192, D = 4096, M = BATCH * SEQ;
constexpr int SELF_W = 3072, XA_W = 1024, MEM_LEN = 256, XA_HD = 256;
constexpr int PG = 768;
constexpr int HD = 128, NQH = 24, NKVH = 3, KV_W = 384, WINDOW = 128;
constexpr int N_IN1 = SELF_W + 2 * KV_W + XA_W;
constexpr int FF = 16384;
constexpr float EPS = 1e-6f;
constexpr int DUP_CONV = 1, DUP_UP = 1, DUP_PROJ = 1, DUP_SWA = 1, DUP_POOLP = 1;

constexpr size_t MiB = 1u << 20;
constexpr size_t WS_CTL = 0, CTL_ZERO_BYTES = 64 * 1024;
constexpr size_t WS_RSTD = 1 * MiB;
constexpr size_t WS_SSQP = 2 * MiB;
constexpr size_t WS_ROPE = 6 * MiB;
constexpr size_t WS_MEMN = 8 * MiB;
constexpr size_t WS_MEMK = 16 * MiB;
constexpr size_t WS_VT = 18 * MiB;
constexpr size_t WS_WKV = 20 * MiB;
constexpr size_t WS_WIN0 = 52 * MiB;
constexpr size_t WS_WG = 84 * MiB;
constexpr size_t WS_WOUT0 = 89 * MiB;
constexpr size_t WS_WIN1 = 121 * MiB;
constexpr size_t WS_WOUT1 = 159 * MiB;
constexpr size_t WS_W1 = 191 * MiB;
constexpr size_t WS_W2 = 447 * MiB;
constexpr size_t WS_XN = 703 * MiB;
constexpr size_t WS_PROJ = 831 * MiB;
constexpr size_t WS_PBUF = 983 * MiB;
constexpr size_t WS_PM = 1079 * MiB;
constexpr size_t WS_Y = 1111 * MiB;
constexpr size_t WS_HID = 1239 * MiB;
constexpr size_t WS_END = 1751 * MiB;
static_assert(WS_Y + (size_t)M * D * 2 <= WS_END && WS_HID + (size_t)M * FF * 2 <= WS_END, "ws map");

constexpr int CW_TMO = 0, CW_CODE = 1;
constexpr int CW_BAR = 4096;

constexpr int RING_OFF = 0, RING_BYTES = 131072;
constexpr int LDSCTL_OFF = RING_BYTES, MISC_OFF = LDSCTL_OFF + 320;
constexpr int LDS_BYTES = 147456;

#define GAS __attribute__((address_space(1)))
#define LAS __attribute__((address_space(3)))
typedef unsigned short bf16;
typedef unsigned v4u __attribute__((ext_vector_type(4)));
typedef unsigned v2u __attribute__((ext_vector_type(2)));
typedef float f32x4 __attribute__((ext_vector_type(4)));
typedef GAS unsigned gu32;
#define RLX_AGENT __ATOMIC_RELAXED, __HIP_MEMORY_SCOPE_AGENT
#define LDS_WAIT() asm volatile("s_waitcnt lgkmcnt(0)" ::: "memory")
#define VM_WAIT() asm volatile("s_waitcnt vmcnt(0)" ::: "memory")
__device__ __forceinline__ unsigned f2bf(float f) { unsigned u = __builtin_bit_cast(unsigned, f); return (u + 0x7fffu + ((u >> 16) & 1u)) >> 16; }
__device__ __forceinline__ unsigned pk2(float lo, float hi) { return f2bf(lo) | (f2bf(hi) << 16); }
__device__ __forceinline__ float bflo(unsigned w) { return __builtin_bit_cast(float, w << 16); }
__device__ __forceinline__ float bfhi(unsigned w) { return __builtin_bit_cast(float, w & 0xffff0000u); }

#define XB_TMO      128
#define XB_XCNT(j)  (256  + 64 * (j))
#define XB_XSUB(j)  (1280 + 64 * (j))
#define XB_XGEN(j)  (2304 + 64 * (j))
#define XB_TOP      3328
#define XB_TOPGEN   3392
#define XCD_BAR_WORDS 3456
#define XB_LSUB(j)  (3584 + 64 * (j))
#define XB_LGEN(j)  (4608 + 64 * (j))
#define XB_ALL_WORDS 5632
#define XB_SPIN_CAP (1u << 18)

__device__ __forceinline__ unsigned xb_ld(unsigned* p)              { return __hip_atomic_load(p, __ATOMIC_RELAXED, __HIP_MEMORY_SCOPE_AGENT); }
__device__ __forceinline__ unsigned xb_add(unsigned* p, unsigned v) { return __hip_atomic_fetch_add(p, v, __ATOMIC_RELAXED, __HIP_MEMORY_SCOPE_AGENT); }
__device__ __forceinline__ unsigned xb_xcc_id() { return (unsigned)__builtin_amdgcn_s_getreg((3 << 11) | 20) & 0xFu; }
#define XB_SPIN(cond, bar) do { unsigned _sp = 0; while (cond) { \
    if ((++_sp & 255u) == 0u) { if (xb_ld(&(bar)[XB_TMO])) break; if (_sp > XB_SPIN_CAP) { atomicAdd(&(bar)[XB_TMO], 1u); break; } } } } while (0)

struct XcdBarrier { unsigned* bar; unsigned x; volatile LAS unsigned* st; };

__device__ __forceinline__ XcdBarrier xcd_barrier_post(unsigned* bar, volatile LAS unsigned* st) {
    XcdBarrier b; b.bar = bar; b.x = xb_xcc_id(); b.st = st;
    if (threadIdx.x == 0) st[2] = xb_add(&bar[XB_XCNT(b.x)], 1u);
    return b;
}
__device__ __forceinline__ void xcd_barrier_complete(unsigned* bar, unsigned x, unsigned& nloc, unsigned& nx, unsigned& balanced) {
    const unsigned G = gridDim.x * gridDim.y * gridDim.z;
    unsigned sum, cnt, mine, sp = 0u, eq;
    for (;;) {
        sum = 0u; cnt = 0u; mine = 0u; eq = 1u;
#pragma unroll
        for (unsigned j = 0; j < 16; ++j) { const unsigned c = xb_ld(&bar[XB_XCNT(j)]); sum += c; cnt += (c > 0u) ? 1u : 0u; mine = (j == x) ? c : mine; eq &= (j < 8u) ? (c * 8u == G ? 1u : 0u) : (c == 0u ? 1u : 0u); }
        if (sum == G) break;
        __builtin_amdgcn_s_sleep(1);
        if ((++sp & 255u) == 0u) { if (xb_ld(&bar[XB_TMO])) break; if (sp > XB_SPIN_CAP) { atomicAdd(&bar[XB_TMO], 1u); break; } }
    }
    nloc = mine > 0u ? mine : 1u; nx = cnt > 0u ? cnt : 1u; balanced = (sum == G) ? eq : 0u;
}
template <bool FIRST> __device__ __forceinline__ void xcd_barrier(const XcdBarrier& b, const int t_) {
    asm volatile("s_waitcnt vmcnt(0)" ::: "memory");
    __syncthreads();
    if (t_ == 0) {
        unsigned* bar = b.bar; unsigned bx_ = b.x; asm volatile("" : "+s"(bx_));
        __builtin_amdgcn_s_waitcnt(0);
        unsigned nloc = b.st[0], nx = b.st[1];
        if constexpr (FIRST) { if (nloc == 0u) { unsigned bal_; xcd_barrier_complete(bar, bx_, nloc, nx, bal_); b.st[0] = nloc; b.st[1] = nx; b.st[3] = bal_; } }
        else { nloc = nloc ? nloc : 1u; nx = nx ? nx : 1u; }
        const unsigned old = xb_add(&bar[XB_XSUB(bx_)], 1u);
        const unsigned gen = old / nloc;
        if (old + 1u == (gen + 1u) * nloc) {
            __builtin_amdgcn_fence(__ATOMIC_RELEASE, "agent");
            asm volatile("s_waitcnt vmcnt(0)" ::: "memory");
            const unsigned og = xb_add(&bar[XB_TOP], 1u);
            const unsigned tg = og / nx;
            if (og + 1u == (tg + 1u) * nx) xb_add(&bar[XB_TOPGEN], 1u);
            else XB_SPIN(xb_ld(&bar[XB_TOPGEN]) == tg, bar);
            __builtin_amdgcn_fence(__ATOMIC_ACQUIRE, "agent");
            xb_add(&bar[XB_XGEN(bx_)], 1u);
            asm volatile("s_waitcnt vmcnt(0)" ::: "memory");
        } else {
            XB_SPIN(xb_ld(&bar[XB_XGEN(bx_)]) == gen, bar);
            __builtin_amdgcn_fence(__ATOMIC_ACQUIRE, "agent");
            asm volatile("s_waitcnt vmcnt(0)" ::: "memory");
        }
    }
    __syncthreads();
}

__device__ __forceinline__ void xcd_local_barrier(const XcdBarrier& b, const int t_) {
    asm volatile("s_waitcnt vmcnt(0)" ::: "memory");
    __syncthreads();
    if (t_ == 0) {
        unsigned* bar = b.bar; unsigned bx_ = b.x; asm volatile("" : "+s"(bx_));
        __builtin_amdgcn_s_waitcnt(0);
        unsigned nloc = b.st[0]; nloc = nloc ? nloc : 1u;
        const unsigned old = xb_add(&bar[XB_LSUB(bx_)], 1u);
        const unsigned gen = old / nloc;
        if (old + 1u == (gen + 1u) * nloc) {
            __builtin_amdgcn_fence(__ATOMIC_RELEASE, "agent");
            asm volatile("s_waitcnt vmcnt(0)" ::: "memory");
            __builtin_amdgcn_fence(__ATOMIC_ACQUIRE, "agent");
            xb_add(&bar[XB_LGEN(bx_)], 1u);
            asm volatile("s_waitcnt vmcnt(0)" ::: "memory");
        } else {
            XB_SPIN(xb_ld(&bar[XB_LGEN(bx_)]) == gen, bar);
            __builtin_amdgcn_fence(__ATOMIC_ACQUIRE, "agent");
            asm volatile("s_waitcnt vmcnt(0)" ::: "memory");
        }
    }
    __syncthreads();
}

__device__ __forceinline__ float wave_sum(float v) {
    v += SWZ_XOR(v, 1); v += SWZ_XOR(v, 2); v += SWZ_XOR(v, 4); v += SWZ_XOR(v, 8); v += SWZ_XOR(v, 16);
    return xor32_add(v);
}
__device__ __forceinline__ float wave_max(float v) {
    v = fmaxf(v, SWZ_XOR(v, 1)); v = fmaxf(v, SWZ_XOR(v, 2)); v = fmaxf(v, SWZ_XOR(v, 4)); v = fmaxf(v, SWZ_XOR(v, 8)); v = fmaxf(v, SWZ_XOR(v, 16));
    return xor32_max(v);
}

__device__ __forceinline__ float rope_inv_freq(int i) {
    float v = 1.000000000e+00f;
    v = (i == 1) ? 4.403665960e-01f : v; v = (i == 2) ? 1.939227432e-01f : v; v = (i == 3) ? 8.539710194e-02f : v; v = (i == 4) ? 3.760603070e-02f : v;
    v = (i == 5) ? 1.656044088e-02f : v; v = (i == 6) ? 7.292664610e-03f : v; v = (i == 7) ? 3.211446106e-03f : v; v = (i == 8) ? 1.414213562e-03f : v;
    v = (i == 9) ? 6.227724371e-04f : v; v = (i == 10) ? 2.742481884e-04f : v; v = (i == 11) ? 1.207697351e-04f : v; v = (i == 12) ? 5.318295734e-05f : v;
    v = (i == 13) ? 2.341999971e-05f : v; v = (i == 14) ? 1.031338525e-05f : v; v = (i == 15) ? 4.541670478e-06f : v;
    return v;
}
__device__ __forceinline__ void sincos_f32arg(float ang, float& s, float& c) {
    const double a = (double)ang; const double n = rint(a * 0.15915494309189535);
    const double r = fma(-n, 6.283185307179586, a) - n * 2.4492935982947064e-16;
    const double r2 = r * r; double ts = r, ss = r, tc = 1.0, cc = 1.0;
#pragma unroll
    for (int k = 1; k <= 13; ++k) { ts *= -r2 * (1.0 / (double)((2 * k) * (2 * k + 1))); ss += ts; tc *= -r2 * (1.0 / (double)((2 * k - 1) * (2 * k))); cc += tc; }
    s = (float)ss; c = (float)cc;
}

__device__ __forceinline__ void transpose_item(const float* W, int K, int N, bf16* WT, LAS float* scr, int item, int lane, const float* gk = nullptr, int ldn = 0) {
    const int nblk = N / 32, kb = item / nblk, nb = item % nblk, k0 = 64 * kb, n0 = 32 * nb; const int pitch = ldn ? ldn : N;
    const int c = lane & 7;
    f32x4 g0 = {1.f, 1.f, 1.f, 1.f}, g1 = {1.f, 1.f, 1.f, 1.f};
    if (gk) { g0 = *(const GAS f32x4*)(gk + k0 + 8 * c); g1 = *(const GAS f32x4*)(gk + k0 + 8 * c + 4); }
    { f32x4 v[8];
#pragma unroll
      for (int j = 0; j < 8; ++j) v[j] = *(const GAS f32x4*)(W + (size_t)(k0 + 8 * j + (lane >> 3)) * pitch + n0 + 4 * (lane & 7));
#pragma unroll
      for (int j = 0; j < 8; ++j) { LAS float* d = scr + (8 * j + (lane >> 3)) * 33 + 4 * (lane & 7); d[0] = v[j].x; d[1] = v[j].y; d[2] = v[j].z; d[3] = v[j].w; } }
    LDS_WAIT(); asm volatile("" ::: "memory");
#pragma unroll
    for (int j = 0; j < 4; ++j) { const int n = (lane >> 3) + 8 * j; const LAS float* s = scr + (8 * c) * 33 + n;
        v4u o; o.x = pk2(s[0 * 33] * g0.x, s[1 * 33] * g0.y); o.y = pk2(s[2 * 33] * g0.z, s[3 * 33] * g0.w); o.z = pk2(s[4 * 33] * g1.x, s[5 * 33] * g1.y); o.w = pk2(s[6 * 33] * g1.z, s[7 * 33] * g1.w);
        *(GAS v4u*)(WT + (size_t)(n0 + n) * K + k0 + 8 * c) = o; }
    LDS_WAIT(); asm volatile("" ::: "memory");
}

__device__ __forceinline__ float row_prep(const float* xrow, const float* g, bf16* orow, bool norm, int lane) {
    const GAS f32x4* xr = (const GAS f32x4*)xrow + lane;
    f32x4 v[16]; float s = 0.f;
#pragma unroll
    for (int j = 0; j < 16; ++j) { v[j] = xr[64 * j]; s += (v[j].x * v[j].x + v[j].y * v[j].y) + (v[j].z * v[j].z + v[j].w * v[j].w); }
    const float rstd = 1.0f / sqrtf(wave_sum(s) * (1.f / D) + EPS);
    const float sc = norm ? rstd : 1.0f;
    const GAS f32x4* gr = (const GAS f32x4*)g + lane;
    GAS v2u* o8 = (GAS v2u*)orow + lane;
#pragma unroll
    for (int j = 0; j < 16; ++j) { const f32x4 gg = g ? gr[64 * j] : (f32x4){1.f, 1.f, 1.f, 1.f}; v2u o; o.x = pk2(v[j].x * gg.x * sc, v[j].y * gg.y * sc); o.y = pk2(v[j].z * gg.z * sc, v[j].w * gg.w * sc); o8[64 * j] = o; }
    return rstd;
}

using pg8::Unit; using pg8::bf16_t;
template <int MODE> struct EpiRowScale {
    static constexpr bool AFTER_DRAIN = false;
    bf16_t* O; int ldc; const float* rstd; const float* cosT; const float* sinT;
    __device__ __forceinline__ void operator()(const f32x4 (&acc)[2][2][4][2], const Unit& u, int wr, int wc, int fr, int fq) const {
        const int row0 = u.pm * 256 + wr * 64 + fr, col0 = u.pn * 256 + wc * 32 + 8 * fq;
        float rsv[2][4];
#pragma unroll
        for (int ai = 0; ai < 2; ++ai)
#pragma unroll
            for (int m = 0; m < 4; ++m) rsv[ai][m] = rstd[row0 + ai * 128 + m * 16];
        f32x4 tn[3][4];
        const bool rope = (MODE == 2) && (wc == 0);
#define ROPE_LD(dst, g_) do { const int r_ = row0 + ((g_) >> 2) * 128 + ((g_) & 3) * 16; const float* cp_ = cosT + (size_t)r_ * 16 + 8 * (fq & 1); const float* sp_ = sinT + (size_t)r_ * 16 + 8 * (fq & 1); \
        dst[0] = *(const f32x4*)cp_; dst[1] = *(const f32x4*)(cp_ + 4); dst[2] = *(const f32x4*)sp_; dst[3] = *(const f32x4*)(sp_ + 4); } while (0)
        if (MODE == 2) { if (rope) { ROPE_LD(tn[0], 0); ROPE_LD(tn[1], 1); ROPE_LD(tn[2], 2); } }
#pragma unroll
        for (int ai = 0; ai < 2; ++ai)
#pragma unroll
            for (int m = 0; m < 4; ++m) { const int row = row0 + ai * 128 + m * 16; const float rs = rsv[ai][m]; bf16_t* rowp = O + (size_t)row * ldc + col0;
                f32x4 c0, c1, s0, s1;
                if (MODE == 2) { if (rope) { constexpr int RB = 0; (void)RB; const int g_ = ai * 4 + m; c0 = tn[g_ % 3][0]; c1 = tn[g_ % 3][1]; s0 = tn[g_ % 3][2]; s1 = tn[g_ % 3][3]; if (fq < 2) { s0 = -s0; s1 = -s1; }
                    if (g_ + 3 < 8) ROPE_LD(tn[g_ % 3], g_ + 3); } }
#pragma unroll
                for (int bj = 0; bj < 2; ++bj) { f32x4 v0 = acc[ai][bj][m][0] * rs, v1 = acc[ai][bj][m][1] * rs;
                    if (MODE == 1) {
#pragma unroll
                        for (int j = 0; j < 4; ++j) { const float a = fmaxf(v0[j], 0.f), b = fmaxf(v1[j], 0.f); v0[j] = a * a; v1[j] = b * b; } }
                    if (MODE == 2) { if (wc == 0 && (2 * u.pn + bj) < 27) {
                        f32x4 o0, o1;
#pragma unroll
                        for (int j = 0; j < 4; ++j) { o0[j] = xor32_other(v0[j], fq < 2); o1[j] = xor32_other(v1[j], fq < 2); }
                        v0 = v0 * c0 + o0 * s0; v1 = v1 * c1 + o1 * s1; } }
                    pg8::st_bf16x8(rowp + bj * 128, v0, v1); } }
#undef ROPE_LD
    }
};
template <bool BASE_F32, bool OUT_F32> struct EpiResid {
    static constexpr bool AFTER_DRAIN = false;
    const void* base; void* out; float* ssqp;
    __device__ __forceinline__ void operator()(const f32x4 (&acc)[2][2][4][2], const Unit& u, int wr, int wc, int fr, int fq) const {
        const int row0 = u.pm * 256 + wr * 64 + fr, col0 = u.pn * 256 + wc * 32 + 8 * fq;
#pragma unroll
        for (int ai = 0; ai < 2; ++ai) {
            f32x4 bf[BASE_F32 ? 4 : 1][2][2]; pg8::u32x4 bq[BASE_F32 ? 1 : 4][2];
#pragma unroll
            for (int m = 0; m < 4; ++m)
#pragma unroll
                for (int bj = 0; bj < 2; ++bj) { const size_t off = (size_t)(row0 + ai * 128 + m * 16) * D + col0 + bj * 128;
                    if (BASE_F32) { bf[m][bj][0] = *(const f32x4*)((const float*)base + off); bf[m][bj][1] = *(const f32x4*)((const float*)base + off + 4); }
                    else bq[m][bj] = *(const pg8::u32x4*)((const bf16_t*)base + off); }
#pragma unroll
            for (int m = 0; m < 4; ++m) { const int row = row0 + ai * 128 + m * 16; const size_t off = (size_t)row * D + col0; float ss = 0.f;
#pragma unroll
                for (int bj = 0; bj < 2; ++bj) { f32x4 b0, b1;
                    if (BASE_F32) { b0 = bf[m][bj][0]; b1 = bf[m][bj][1]; }
                    else { const pg8::u32x4 w = bq[m][bj];
                        b0 = (f32x4){__uint_as_float(w.x << 16), __uint_as_float(w.x & 0xffff0000u), __uint_as_float(w.y << 16), __uint_as_float(w.y & 0xffff0000u)};
                        b1 = (f32x4){__uint_as_float(w.z << 16), __uint_as_float(w.z & 0xffff0000u), __uint_as_float(w.w << 16), __uint_as_float(w.w & 0xffff0000u)}; }
                    const f32x4 h0 = b0 + acc[ai][bj][m][0], h1 = b1 + acc[ai][bj][m][1];
                    ss += (h0[0] * h0[0] + h0[1] * h0[1]) + (h0[2] * h0[2] + h0[3] * h0[3]) + (h1[0] * h1[0] + h1[1] * h1[1]) + (h1[2] * h1[2] + h1[3] * h1[3]);
                    if (OUT_F32) { *(f32x4*)((float*)out + off + bj * 128) = h0; *(f32x4*)((float*)out + off + bj * 128 + 4) = h1; }
                    else pg8::st_bf16x8((bf16_t*)out + off + bj * 128, h0, h1); }
                ss = xor32_add(xor16_add(ss));
                if (fq == 0) ssqp[(size_t)row * 64 + u.pn * 4 + wc] = ss; }
            asm volatile("" ::: "memory"); }
    }
};
struct EpiPool {
    static constexpr bool AFTER_DRAIN = false;
    bf16_t* Y; const float* scale;
    __device__ __forceinline__ void operator()(const f32x4 (&acc)[2][2][4][2], const Unit& u, int wr, int wc, int fr, int fq) const {
        const int row0 = u.pm * 256 + wr * 64 + fr, col0 = u.z * PG + u.pn * 256 + wc * 32 + 8 * fq;
        f32x4 sv[2][2];
#pragma unroll
        for (int bj = 0; bj < 2; ++bj) { sv[bj][0] = *(const f32x4*)(scale + col0 + bj * 128); sv[bj][1] = *(const f32x4*)(scale + col0 + bj * 128 + 4); }
#pragma unroll
        for (int ai = 0; ai < 2; ++ai)
#pragma unroll
            for (int m = 0; m < 4; ++m) { bf16_t* rowp = Y + (size_t)(row0 + ai * 128 + m * 16) * D + col0;
#pragma unroll
                for (int bj = 0; bj < 2; ++bj) pg8::st_bf16x8(rowp + bj * 128, acc[ai][bj][m][0] * sv[bj][0], acc[ai][bj][m][1] * sv[bj][1]); }
    }
};
struct EpiMemKV {
    static constexpr bool AFTER_DRAIN = false;
    bf16_t* memk; bf16_t* vt;
    __device__ __forceinline__ void operator()(const f32x4 (&acc)[2][2][4][2], const Unit& u, int wr, int wc, int fr, int fq) const {
        const int layer = u.z >> 1, part = u.z & 1; const int ldc = part ? 512 : 1024;
        bf16_t* O = part ? vt + (size_t)layer * 1024 * 512 : memk + (size_t)layer * 512 * 1024;
        const int row0 = u.pm * 256 + wr * 64 + fr, col0 = u.pn * 256 + wc * 32 + 8 * fq;
#pragma unroll
        for (int ai = 0; ai < 2; ++ai)
#pragma unroll
            for (int m = 0; m < 4; ++m) { bf16_t* rowp = O + (size_t)(row0 + ai * 128 + m * 16) * ldc + col0;
#pragma unroll
                for (int bj = 0; bj < 2; ++bj) pg8::st_bf16x8(rowp + bj * 128, acc[ai][bj][m][0], acc[ai][bj][m][1]); }
    }
};

struct EpiXS {
    static constexpr bool AFTER_DRAIN = true;
    bf16_t* PM;
    __device__ __forceinline__ void fused(f32x4 (&acc)[2][2][4][2], const Unit& u, int wr, int wc, int fr, int fq, PG8_LAS unsigned char* lds, int wid, int lane) const {
        typedef float f32x2v __attribute__((ext_vector_type(2)));
        PG8_LAS f32x2v* T = (PG8_LAS f32x2v*)lds;
        const float c2 = 0.0625f * 1.4426950408889634f;
        float wm[2][4];
#pragma unroll
        for (int ai = 0; ai < 2; ++ai)
#pragma unroll
            for (int m = 0; m < 4; ++m) {
                float mx = -__builtin_inff();
#pragma unroll
                for (int bj = 0; bj < 2; ++bj)
#pragma unroll
                    for (int n = 0; n < 2; ++n) { const f32x4 v = acc[ai][bj][m][n]; mx = fmaxf(mx, fmaxf(fmaxf(v[0], v[1]), fmaxf(v[2], v[3]))); }
                mx = xor32_max(xor16_max(mx));
                float sm = 0.f;
#pragma unroll
                for (int bj = 0; bj < 2; ++bj)
#pragma unroll
                    for (int n = 0; n < 2; ++n) { f32x4 v = acc[ai][bj][m][n];
#pragma unroll
                        for (int j = 0; j < 4; ++j) { v[j] = __builtin_amdgcn_exp2f((v[j] - mx) * c2); sm += v[j]; }
                        acc[ai][bj][m][n] = v; }
                sm = xor32_add(xor16_add(sm));
                wm[ai][m] = mx;
                if (fq == 0) T[(ai * 128 + wr * 64 + m * 16 + fr) * 4 + wc] = (f32x2v){mx, sm};
            }
        asm volatile("s_waitcnt lgkmcnt(0)" ::: "memory"); __builtin_amdgcn_s_barrier(); asm volatile("" ::: "memory");
#pragma unroll
        for (int ai = 0; ai < 2; ++ai)
#pragma unroll
            for (int m = 0; m < 4; ++m) { const int r = ai * 128 + wr * 64 + m * 16 + fr;
                const f32x2v t0 = T[r * 4 + 0], t1 = T[r * 4 + 1], t2 = T[r * 4 + 2], t3 = T[r * 4 + 3];
                const float M = fmaxf(fmaxf(t0.x, t1.x), fmaxf(t2.x, t3.x));
                const float tot = (t0.y * __builtin_amdgcn_exp2f((t0.x - M) * c2) + t1.y * __builtin_amdgcn_exp2f((t1.x - M) * c2)) + (t2.y * __builtin_amdgcn_exp2f((t2.x - M) * c2) + t3.y * __builtin_amdgcn_exp2f((t3.x - M) * c2));
                const float f = __builtin_amdgcn_exp2f((wm[ai][m] - M) * c2) / tot;
                bf16_t* rowp = PM + (size_t)(u.pm * 256 + r) * XA_W + u.z * XA_HD + wc * 32 + 8 * fq;
#pragma unroll
                for (int bj = 0; bj < 2; ++bj) pg8::st_bf16x8(rowp + bj * 128, acc[ai][bj][m][0] * f, acc[ai][bj][m][1] * f); }
        asm volatile("s_waitcnt lgkmcnt(0)" ::: "memory"); __builtin_amdgcn_s_barrier(); asm volatile("" ::: "memory");
    }
};
struct EpiXV {
    static constexpr bool AFTER_DRAIN = false;
    bf16_t* Y;
    __device__ __forceinline__ void operator()(const f32x4 (&acc)[2][2][4][2], const Unit& u, int wr, int wc, int fr, int fq) const {
        const int row0 = u.pm * 256 + wr * 64 + fr, col0 = SELF_W + u.z * XA_HD + wc * 32 + 8 * fq;
#pragma unroll
        for (int ai = 0; ai < 2; ++ai)
#pragma unroll
            for (int m = 0; m < 4; ++m) { bf16_t* rowp = Y + (size_t)(row0 + ai * 128 + m * 16) * D + col0;
#pragma unroll
                for (int bj = 0; bj < 2; ++bj) pg8::st_bf16x8(rowp + bj * 128, acc[ai][bj][m][0], acc[ai][bj][m][1]); }
    }
};
struct XOrder {
    int G, c, i0; bool one; const char* A; size_t lda; size_t a_hoff; const char* B; size_t b_boff, b_hoff;
    __device__ __forceinline__ bool next(int i, Unit& u) const {
        if (one && i > 0) return false;
        const int L = (i + i0) * G + c; if (L >= 256) return false;
        const int b = L >> 7, h = (L >> 5) & 3, rp = L & 31; u.pm = b * 32 + rp; u.pn = 0; u.z = h;
        u.a = A + (size_t)u.pm * 256 * lda + (size_t)h * a_hoff; u.b = B + (size_t)b * b_boff + (size_t)h * b_hoff; return true;
    }
};

struct EpiProd {
    static constexpr bool AFTER_DRAIN = false;
    bf16_t* WT; const float* rscale; const float* cgain;
    __device__ __forceinline__ void operator()(const f32x4 (&acc)[2][2][4][2], const Unit& u, int wr, int wc, int fr, int fq) const {
        const int row0 = u.z * PG + u.pm * 256 + wr * 64 + fr, col0 = u.pn * 256 + wc * 32 + 8 * fq;
        float rs[2][4]; f32x4 cg[2][2];
#pragma unroll
        for (int ai = 0; ai < 2; ++ai)
#pragma unroll
            for (int m = 0; m < 4; ++m) rs[ai][m] = rscale[row0 + ai * 128 + m * 16];
#pragma unroll
        for (int bj = 0; bj < 2; ++bj) { cg[bj][0] = *(const f32x4*)(cgain + col0 + bj * 128); cg[bj][1] = *(const f32x4*)(cgain + col0 + bj * 128 + 4); }
#pragma unroll
        for (int ai = 0; ai < 2; ++ai)
#pragma unroll
            for (int m = 0; m < 4; ++m) { bf16_t* rowp = WT + (size_t)(row0 + ai * 128 + m * 16) * D + col0;
#pragma unroll
                for (int bj = 0; bj < 2; ++bj) pg8::st_bf16x8(rowp + bj * 128, acc[ai][bj][m][0] * rs[ai][m] * cg[bj][0], acc[ai][bj][m][1] * rs[ai][m] * cg[bj][1]); }
    }
};
struct ProdOrder {
    int G, c; const char* wgt; const char* winn;
    __device__ __forceinline__ bool next(int i, Unit& u) const {
        const int L = i * G + c; if (L >= 192) return false;
        const int g = L / 48, r = L - g * 48; u.z = g; u.pm = r >> 4; u.pn = r & 15;
        u.a = wgt + (size_t)(g * PG + u.pm * 256) * (PG * 2); u.b = winn + (size_t)(u.pn * 256) * (SELF_W * 2) + (size_t)g * PG * 2; return true;
    }
};

struct MemKVOrder {
    int G, c; const char* memn; const char* wkv;
    __device__ __forceinline__ bool next(int i, Unit& u) const {
        const int L = i * G + c; if (L >= 32) return false;
        const int layer = L >> 4, part = (L >> 3) & 1, q = L & 7;
        const char* mn = memn + (size_t)layer * 512 * 8192; const char* w = wkv + (size_t)layer * 2048 * 8192;
        if (part == 0) { u.pm = q >> 2; u.pn = q & 3; u.a = mn + (size_t)u.pm * 256 * 8192; u.b = w + (size_t)u.pn * 256 * 8192; }
        else { u.pm = q >> 1; u.pn = q & 1; u.a = w + (size_t)(1024 + u.pm * 256) * 8192; u.b = mn + (size_t)u.pn * 256 * 8192; }
        u.z = layer * 2 + part; return true;
    }
};
struct PoolOrder {
    int G, c; const char* pbuf; const char* wg;
    __device__ __forceinline__ bool next(int i, Unit& u) const {
        const int L = i * G + c; if (L >= 768) return false;
        u.pn = L % 3; const int g = (L / 3) & 3; u.pm = L / 12; u.z = g;
        u.a = pbuf + (size_t)u.pm * 256 * (SELF_W * 2) + (size_t)g * PG * 2; u.b = wg + (size_t)(g * PG + u.pn * 256) * (PG * 2); return true;
    }
};

struct Args { const void* in[17]; float* out; unsigned char* ws; };

__global__ void __launch_bounds__(NWAVES * 64, 2) fwd_kernel(Args args_unused) {
    extern __shared__ __attribute__((aligned(16))) unsigned char lds_raw[];
    LAS unsigned char* lds = (LAS unsigned char*)lds_raw;
    volatile LAS unsigned* MISC = (volatile LAS unsigned*)(lds + MISC_OFF);
    const int tid0 = threadIdx.x;
    const int wave0 = __builtin_amdgcn_readfirstlane(tid0 >> 6);
#define PHASE_TID() int wave = wave0; asm volatile("" : "+s"(wave)); int lane; asm volatile("v_mbcnt_lo_u32_b32 %0, -1, 0\n\tv_mbcnt_hi_u32_b32 %0, -1, %0" : "=v"(lane)); \
    const int tid = wave * 64 + lane; (void)tid
#define KARG(i) (*(const void* const __attribute__((address_space(4)))*)(kp + 8 * (i)))
#define PHASE_IDS() PHASE_TID(); \
    int G = gridDim.x, bx = __builtin_amdgcn_readfirstlane((int)MISC[12]); asm volatile("" : "+s"(G), "+s"(bx));     const int vcu = (G % 8 == 0) ? (bx % 8) * (G / 8) + bx / 8 : bx; (void)vcu; \
    LAS float* scr = (LAS float*)(lds + RING_OFF + wave * 16384); (void)scr; \
    const __attribute__((address_space(4))) char* kp = (const __attribute__((address_space(4))) char*)__builtin_amdgcn_kernarg_segment_ptr(); asm volatile("" : "+s"(kp)); \
    const float* x = (const float*)KARG(0); const float* mem = (const float*)KARG(1); const int* positions = (const int*)KARG(2); \
    const float* norm_mix = (const float*)KARG(3); const float* norm_mem = (const float*)KARG(4); const float* norm_mlp = (const float*)KARG(5); \
    const float* w_mem_kv = (const float*)KARG(6); const float* pool_w_in = (const float*)KARG(7); const float* pool_w_group = (const float*)KARG(8); \
    const float* pool_scale = (const float*)KARG(9); const float* pool_w_out = (const float*)KARG(10); const float* attn_w_in = (const float*)KARG(11); \
    const float* attn_sink = (const float*)KARG(12); const float* attn_w_out = (const float*)KARG(13); const float* mlp_w1 = (const float*)KARG(14); \
    const float* mlp_w2 = (const float*)KARG(15); const float* final_norm = (const float*)KARG(16); float* out = (float*)KARG(17); unsigned char* ws = (unsigned char*)KARG(18); \
    (void)x; (void)mem; (void)positions; (void)norm_mix; (void)norm_mem; (void)norm_mlp; (void)w_mem_kv; (void)pool_w_in; (void)pool_w_group; (void)pool_scale; (void)pool_w_out; \
    (void)attn_w_in; (void)attn_sink; (void)attn_w_out; (void)mlp_w1; (void)mlp_w2; (void)final_norm; (void)out; \
    gu32* ctl = (gu32*)(ws + WS_CTL); (void)ctl; \
    float* RSTD = (float*)(ws + WS_RSTD); float* SSQP = (float*)(ws + WS_SSQP); float* COS = (float*)(ws + WS_ROPE); float* SIN = COS + (size_t)M * 16; \
    bf16* MEMN = (bf16*)(ws + WS_MEMN); bf16* MEMK = (bf16*)(ws + WS_MEMK); bf16* VT = (bf16*)(ws + WS_VT); \
    bf16* WKV = (bf16*)(ws + WS_WKV); bf16* WIN0 = (bf16*)(ws + WS_WIN0); bf16* WGT = (bf16*)(ws + WS_WG); bf16* WOUT0 = (bf16*)(ws + WS_WOUT0); \
    bf16* WIN1 = (bf16*)(ws + WS_WIN1); bf16* WOUT1 = (bf16*)(ws + WS_WOUT1); bf16* W1T = (bf16*)(ws + WS_W1); bf16* W2T = (bf16*)(ws + WS_W2); \
    bf16* XN = (bf16*)(ws + WS_XN); bf16* PROJ = (bf16*)(ws + WS_PROJ); bf16* PBUF = (bf16*)(ws + WS_PBUF); bf16* PM = (bf16*)(ws + WS_PM); \
    bf16* Y = (bf16*)(ws + WS_Y); bf16* HID = (bf16*)(ws + WS_HID); \
    (void)RSTD; (void)SSQP; (void)COS; (void)SIN; (void)MEMN; (void)MEMK; (void)VT; (void)WKV; (void)WIN0; (void)WGT; (void)WOUT0; (void)WIN1; (void)WOUT1; (void)W1T; (void)W2T; \
    (void)XN; (void)PROJ; (void)PBUF; (void)PM; (void)Y; (void)HID
    for (int u = tid0; u < (LDS_BYTES - LDSCTL_OFF) / 4; u += NWAVES * 64) ((LAS unsigned*)(lds + LDSCTL_OFF))[u] = 0u;
    __syncthreads();
    if (tid0 == 0) MISC[12] = blockIdx.x;
    __syncthreads();
    XcdBarrier bar;
    { const __attribute__((address_space(4))) char* kp = (const __attribute__((address_space(4))) char*)__builtin_amdgcn_kernarg_segment_ptr();
      unsigned char* ws0 = (unsigned char*)KARG(18); bar = xcd_barrier_post((unsigned*)((gu32*)(ws0 + WS_CTL) + CW_BAR), MISC + 8); }
#define GRID_BAR() do { PHASE_TID(); xcd_barrier<false>(bar, tid); } while (0)
#define GRID_BAR_FIRST() do { PHASE_TID(); xcd_barrier<true>(bar, tid); if (tid == 0) { const unsigned bal_ = (MISC[11] != 0u && gridDim.x == 256u) ? 1u : 0u; MISC[13] = bal_; if (bal_) MISC[12] = bar.x + 8u * MISC[10]; } __syncthreads(); } while (0)
#define LOCAL_BAR() do { PHASE_TID(); if (__builtin_amdgcn_readfirstlane((int)MISC[13])) xcd_local_barrier(bar, tid); else xcd_barrier<false>(bar, tid); } while (0)

    {
        PHASE_IDS();
        const int gw = vcu * NWAVES + wave, NGW = G * NWAVES;
        constexpr int I_KV = (D / 64) * (2048 / 32);
        for (int it = gw; it < 2 * I_KV; it += NGW) { const int l = it / I_KV, r = it % I_KV; transpose_item(w_mem_kv + (size_t)l * D * 2048, D, 2048, WKV + (size_t)l * 2048 * D, scr, r, lane); }
        for (int it = gw; it < 2 * 512; it += NGW) { const int l = it >> 9, r = it & 511; (void)row_prep(mem + (size_t)r * D, norm_mem + (size_t)l * D, MEMN + ((size_t)l * 512 + r) * D, true, lane); }
        constexpr int I_G = (PG / 64) * (PG / 32);
        for (int it = gw; it < 4 * I_G; it += NGW) { const int g = it / I_G; transpose_item(pool_w_group + (size_t)g * PG * PG, PG, PG, WGT + (size_t)g * PG * PG, scr, it % I_G, lane); }
        for (int e0 = vcu * 512 + tid; e0 < D * (SELF_W / 8); e0 += 4 * G * 512) {
            f32x4 a[4], b[4];
#pragma unroll
            for (int u = 0; u < 4; ++u) { const int e = e0 + u * G * 512; const int ee = (e < D * (SELF_W / 8)) ? e : e0; const int k = ee / (SELF_W / 8), c8 = (ee % (SELF_W / 8)) * 8;
                a[u] = *(const GAS f32x4*)(pool_w_in + (size_t)k * D + c8); b[u] = *(const GAS f32x4*)(pool_w_in + (size_t)k * D + c8 + 4); }
#pragma unroll
            for (int u = 0; u < 4; ++u) { const int e = e0 + u * G * 512; if (e < D * (SELF_W / 8)) { const int k = e / (SELF_W / 8), c8 = (e % (SELF_W / 8)) * 8;
                v4u o; o.x = pk2(a[u].x, a[u].y); o.y = pk2(a[u].z, a[u].w); o.z = pk2(b[u].x, b[u].y); o.w = pk2(b[u].z, b[u].w); *(GAS v4u*)(PBUF + (size_t)k * SELF_W + c8) = o; } } }
    }
    GRID_BAR_FIRST();
    {
        PHASE_IDS();
        const int ngemm = (G >= 64) ? 32 : G;
        if (vcu < ngemm) {
            MemKVOrder S; S.G = ngemm; S.c = vcu; S.memn = (const char*)MEMN; S.wkv = (const char*)WKV;
            EpiMemKV E{MEMK, VT};
            pg8::gemm_phase<EpiMemKV, MemKVOrder>(lds + RING_OFF, tid, 8192u, 8192u, D / 64, S, E);
            __syncthreads();
        }
        if (G >= 64 && vcu < ngemm) {
            PHASE_IDS();
            ProdOrder S; S.G = 32; S.c = vcu; S.wgt = (const char*)WGT; S.winn = (const char*)PBUF; EpiProd E{WIN0, pool_scale, norm_mix};
            pg8::gemm_phase<EpiProd, ProdOrder>(lds + RING_OFF, tid, PG * 2, SELF_W * 2, PG / 64, S, E); __syncthreads();
        }
        if (G < 64 || vcu >= ngemm) {
            const int cw = (G < 64) ? vcu : vcu - ngemm, ncw = (G < 64) ? G : G - ngemm;
            if (G < 64) { ProdOrder S; S.G = ncw; S.c = cw; S.wgt = (const char*)WGT; S.winn = (const char*)PBUF; EpiProd E{WIN0, pool_scale, norm_mix};
              pg8::gemm_phase<EpiProd, ProdOrder>(lds + RING_OFF, tid, PG * 2, SELF_W * 2, PG / 64, S, E); __syncthreads(); }
            const int gw = cw * NWAVES + wave, NGW = ncw * NWAVES;
            constexpr int I_SQ = (D / 64) * (D / 32), I_G = (PG / 64) * (PG / 32), I_IN1 = (D / 64) * (N_IN1 / 32), I_W1 = (D / 64) * (FF / 32), I_W2 = (FF / 64) * (D / 32);
            constexpr int I_XQ = (D / 64) * (XA_W / 32); (void)I_G;
            constexpr int NITEMS = 2 * I_SQ + I_XQ + I_IN1 + 2 * I_W1 + 2 * I_W2;
            for (int rep = 0; rep < DUP_CONV; ++rep)
            for (int it = gw; it < NITEMS; it += NGW) {
                int r = it;
                if (r < 2 * I_W1) { const int l = r / I_W1; transpose_item(mlp_w1 + (size_t)l * D * FF, D, FF, W1T + (size_t)l * FF * D, scr, r % I_W1, lane, norm_mlp + (size_t)l * D); continue; } r -= 2 * I_W1;
                if (r < 2 * I_W2) { const int l = r / I_W2; transpose_item(mlp_w2 + (size_t)l * FF * D, FF, D, W2T + (size_t)l * D * FF, scr, r % I_W2, lane); continue; } r -= 2 * I_W2;
                if (r < I_XQ) { transpose_item(pool_w_in + SELF_W, D, XA_W, WIN0 + (size_t)SELF_W * D, scr, r, lane, norm_mix, D); continue; } r -= I_XQ;
                if (r < I_SQ) { transpose_item(pool_w_out, D, D, WOUT0, scr, r, lane); continue; } r -= I_SQ;
                if (r < I_SQ) { transpose_item(attn_w_out, D, D, WOUT1, scr, r, lane); continue; } r -= I_SQ;
                transpose_item(attn_w_in, D, N_IN1, WIN1, scr, r, lane, norm_mix + D);
            }
            for (int m = gw; m < M; m += NGW) { const float rs = row_prep(x + (size_t)m * D, nullptr, XN + (size_t)m * D, false, lane); if (lane == 0) RSTD[m] = rs; }
            for (int e = cw * 512 + tid; e < M * 16; e += ncw * 512) { const int m = e >> 4, i = e & 15;
                const float ang = (float)positions[m] * rope_inv_freq(i);
                float sn, cs; sincos_f32arg(ang, sn, cs); COS[e] = cs; SIN[e] = sn; }
        }
    }
    GRID_BAR();

    for (int layer = 0; layer < 2; ++layer) {
        const int ldp = (layer == 0) ? D : N_IN1;
        const int xq_off = (layer == 0) ? SELF_W : SELF_W + 2 * KV_W;
        if (layer == 0) {
            for (int rep = 0; rep < DUP_PROJ; ++rep)
            { PHASE_IDS(); pg8::GridOrder S; S.init(M, D, G, bx, XN, D * 2, WIN0, D * 2); EpiRowScale<0> E{PROJ, D, RSTD, nullptr, nullptr};
              pg8::gemm_phase<EpiRowScale<0>, pg8::GridOrder>(lds + RING_OFF, tid, D * 2, D * 2, D / 64, S, E); }
            GRID_BAR();
            { PHASE_IDS();
            const int NITEM = (M / 32) * (SELF_W / 8), ipw = (NITEM + G - 1) / G;
            for (int li = tid; li < ipw; li += 512) { const int item = vcu * ipw + li; if (item >= NITEM) break;
                const int c8 = (item % (SELF_W / 8)) * 8, t0 = (item / (SELF_W / 8)) * 32; const int g = c8 / PG, w = 2 << g, pos0 = t0 & (SEQ - 1);
                const bf16* p = PROJ + (size_t)t0 * D + c8; bf16* q = Y + (size_t)t0 * D + c8;
                float s[8] = {0.f, 0.f, 0.f, 0.f, 0.f, 0.f, 0.f, 0.f};
                {
                    v4u vi[16];
#pragma unroll
                    for (int i = 1; i <= 16; ++i) { const int ii = (i <= w) ? i : w; const int back = (ii <= pos0) ? ii : 0; vi[i - 1] = *(const GAS v4u*)(p - (size_t)back * D); }
#pragma unroll
                    for (int i = 1; i <= 16; ++i) { const float mk = (i <= w && i <= pos0) ? 1.f : 0.f; const v4u v = vi[i - 1];
                        s[0] += mk * bflo(v.x); s[1] += mk * bfhi(v.x); s[2] += mk * bflo(v.y); s[3] += mk * bfhi(v.y); s[4] += mk * bflo(v.z); s[5] += mk * bfhi(v.z); s[6] += mk * bflo(v.w); s[7] += mk * bfhi(v.w); }
                }
#pragma unroll 1
                for (int r0 = 0; r0 < 32; r0 += 8) {
                    v4u vn[8], vo[8];
#pragma unroll
                    for (int j = 0; j < 8; ++j) vn[j] = *(const GAS v4u*)(p + (size_t)(r0 + j) * D);
#pragma unroll
                    for (int j = 0; j < 8; ++j) { const int pos = pos0 + r0 + j; const int rr = (pos >= w) ? r0 + j - w : r0 + j; vo[j] = *(const GAS v4u*)(p + (long)rr * D); }
#pragma unroll
                    for (int j = 0; j < 8; ++j) { const int pos = pos0 + r0 + j; const float mk = (pos >= w) ? 1.f : 0.f; const v4u v = vn[j], ov = vo[j];
                        const float u0[8] = {bflo(v.x), bfhi(v.x), bflo(v.y), bfhi(v.y), bflo(v.z), bfhi(v.z), bflo(v.w), bfhi(v.w)};
                        const float o0[8] = {bflo(ov.x), bfhi(ov.x), bflo(ov.y), bfhi(ov.y), bflo(ov.z), bfhi(ov.z), bflo(ov.w), bfhi(ov.w)};
#pragma unroll
                        for (int e = 0; e < 8; ++e) s[e] = (s[e] + u0[e]) - mk * o0[e];
                        const int cnt = (pos + 1 < w) ? pos + 1 : w; const float ic = 1.0f / (float)cnt; v4u o;
                        o.x = pk2(s[0] * ic - u0[0], s[1] * ic - u0[1]); o.y = pk2(s[2] * ic - u0[2], s[3] * ic - u0[3]); o.z = pk2(s[4] * ic - u0[4], s[5] * ic - u0[5]); o.w = pk2(s[6] * ic - u0[6], s[7] * ic - u0[7]);
                        *(GAS v4u*)(q + (size_t)(r0 + j) * D) = o; }
                }
            } }
            {
              for (int i0 = 0; ; ++i0) {
                  PHASE_IDS(); if (i0 * G + vcu >= 256) break;
                  XOrder S; S.G = G; S.c = vcu; S.i0 = i0; S.one = true; S.A = (const char*)PROJ + (size_t)xq_off * 2; S.lda = (size_t)ldp * 2; S.a_hoff = XA_HD * 2;
                  S.B = (const char*)(MEMK + (size_t)layer * 512 * 1024); S.b_boff = (size_t)256 * 1024 * 2; S.b_hoff = XA_HD * 2;
                  EpiXS E{PM};
                  pg8::gemm_phase<EpiXS, XOrder>(lds + RING_OFF, tid, (unsigned)(ldp * 2), 2048u, 4, S, E); }
              VM_WAIT(); __syncthreads(); }
            { PHASE_IDS();
              XOrder S; S.G = G; S.c = vcu; S.i0 = 0; S.one = false; S.A = (const char*)PM; S.lda = XA_W * 2; S.a_hoff = XA_HD * 2;
              S.B = (const char*)(VT + (size_t)layer * 1024 * 512); S.b_boff = 256 * 2; S.b_hoff = (size_t)XA_HD * 512 * 2;
              EpiXV E{Y};
              pg8::gemm_phase<EpiXV, XOrder>(lds + RING_OFF, tid, XA_W * 2, 1024u, 4, S, E); }
        } else {
            for (int rep = 0; rep < DUP_PROJ; ++rep)
            { PHASE_IDS(); pg8::GridOrder S; S.init(M, N_IN1, G, bx, XN, D * 2, WIN1, D * 2); EpiRowScale<2> E{PROJ, N_IN1, RSTD, COS, SIN};
              pg8::gemm_phase<EpiRowScale<2>, pg8::GridOrder>(lds + RING_OFF, tid, D * 2, D * 2, D / 64, S, E); }
            GRID_BAR();
            {
              for (int i0 = 0; ; ++i0) {
                  PHASE_IDS(); if (i0 * G + vcu >= 256) break;
                  XOrder S; S.G = G; S.c = vcu; S.i0 = i0; S.one = true; S.A = (const char*)PROJ + (size_t)xq_off * 2; S.lda = (size_t)ldp * 2; S.a_hoff = XA_HD * 2;
                  S.B = (const char*)(MEMK + (size_t)layer * 512 * 1024); S.b_boff = (size_t)256 * 1024 * 2; S.b_hoff = XA_HD * 2;
                  EpiXS E{PM};
                  pg8::gemm_phase<EpiXS, XOrder>(lds + RING_OFF, tid, (unsigned)(ldp * 2), 2048u, 4, S, E); }
              VM_WAIT(); __syncthreads(); }
            for (int rep = 0; rep < DUP_SWA; ++rep)
            {
                PHASE_IDS();
                constexpr int NCH = SEQ / 32, NUNITS = BATCH * NKVH * NCH;
                auto ref = [&](int U) { const int g = U / NCH, c = U - g * NCH; const int b = g / NKVH, kvh = g - b * NKVH; const size_t row0 = (size_t)b * SEQ + (size_t)c * 32;
                    swa::BlockRef<swa::bf16, swa::bf16> R; const bf16* base = PROJ + (size_t)(b * SEQ) * N_IN1;
                    R.Q = PROJ + row0 * N_IN1 + kvh * 8 * HD; R.K = base + SELF_W + kvh * HD; R.V = R.K + KV_W; R.O = Y + row0 * D + kvh * 8 * HD; R.P0 = c * 32; R.sink = attn_sink + kvh * 8; return R; };
                const int per = (NUNITS + G - 1) / G; int U = vcu * per; const int Uend = (U + per < NUNITS) ? U + per : NUNITS;
                if (U < Uend) {
                    swa::BlockRef<swa::bf16, swa::bf16> cur = ref(U);
                    swa::Seam<swa::bf16> S;
                    swa::causal_swa_prime<swa::bf16, swa::bf16>(cur, WINDOW, (char*)lds_raw + RING_OFF, S, tid);
                    for (;;) {
                        const bool last = (U + 1 >= Uend);
                        const swa::BlockRef<swa::bf16, swa::bf16> nxt = last ? cur : ref(U + 1);
                        swa::causal_swa_block<swa::bf16, swa::bf16>(cur, nxt, SEQ, WINDOW, (char*)lds_raw + RING_OFF, S, tid);
                        if (last) break;
                        cur = nxt; ++U;
                    }
                }
            }
            { PHASE_IDS();
              XOrder S; S.G = G; S.c = vcu; S.i0 = 0; S.one = false; S.A = (const char*)PM; S.lda = XA_W * 2; S.a_hoff = XA_HD * 2;
              S.B = (const char*)(VT + (size_t)layer * 1024 * 512); S.b_boff = 256 * 2; S.b_hoff = (size_t)XA_HD * 512 * 2;
              EpiXV E{Y};
              pg8::gemm_phase<EpiXV, XOrder>(lds + RING_OFF, tid, XA_W * 2, 1024u, 4, S, E); }
        }
        GRID_BAR();
        { PHASE_IDS(); pg8::GridOrder S; S.init(M, D, G, bx, Y, D * 2, layer == 0 ? WOUT0 : WOUT1, D * 2);
          EpiResid<false, false> E{XN, XN, SSQP}; pg8::gemm_phase<EpiResid<false, false>, pg8::GridOrder>(lds + RING_OFF, tid, D * 2, D * 2, D / 64, S, E); }
        LOCAL_BAR();
        { PHASE_IDS();
          if (G == 256) { if (tid < 64) { const int r = (bx & 7) * 2048 + (bx >> 3) * 64 + tid; const f32x4* p = (const f32x4*)(SSQP + (size_t)r * 64); float s = 0.f;
#pragma unroll
              for (int j = 0; j < 16; ++j) { const f32x4 v = p[j]; s += (v.x + v.y) + (v.z + v.w); }
              RSTD[r] = 1.0f / sqrtf(s * (1.f / D) + EPS); } }
          else { for (int r = vcu * 512 + tid; r < M; r += G * 512) { const f32x4* p = (const f32x4*)(SSQP + (size_t)r * 64); float s = 0.f;
#pragma unroll
              for (int j = 0; j < 16; ++j) { const f32x4 v = p[j]; s += (v.x + v.y) + (v.z + v.w); }
              RSTD[r] = 1.0f / sqrtf(s * (1.f / D) + EPS); } } }
        LOCAL_BAR();
        { PHASE_TID(); const int bxs = __builtin_amdgcn_readfirstlane((int)MISC[12]); const int dl = ((bxs >> 6) & 3) * 2; for (int i = 0; i < dl; ++i) __builtin_amdgcn_s_sleep(32); }
        for (int rep = 0; rep < DUP_UP; ++rep)
        { PHASE_IDS(); pg8::GridOrder S; S.init(M, FF, G, bx, XN, D * 2, W1T + (size_t)layer * FF * D, D * 2); EpiRowScale<1> E{HID, FF, RSTD, nullptr, nullptr};
          pg8::gemm_phase<EpiRowScale<1>, pg8::GridOrder>(lds + RING_OFF, tid, D * 2, D * 2, D / 64, S, E); }
        LOCAL_BAR();
        { PHASE_IDS(); pg8::GridOrder S; S.init(M, D, G, bx, HID, FF * 2, W2T + (size_t)layer * D * FF, FF * 2);
          EpiResid<false, false> E{XN, XN, SSQP}; pg8::gemm_phase<EpiResid<false, false>, pg8::GridOrder>(lds + RING_OFF, tid, FF * 2, FF * 2, FF / 64, S, E); }
        if (layer == 0) {
            LOCAL_BAR();
            { PHASE_IDS();
          if (G == 256) { if (tid < 64) { const int r = (bx & 7) * 2048 + (bx >> 3) * 64 + tid; const f32x4* p = (const f32x4*)(SSQP + (size_t)r * 64); float s = 0.f;
#pragma unroll
              for (int j = 0; j < 16; ++j) { const f32x4 v = p[j]; s += (v.x + v.y) + (v.z + v.w); }
              RSTD[r] = 1.0f / sqrtf(s * (1.f / D) + EPS); } }
          else { for (int r = vcu * 512 + tid; r < M; r += G * 512) { const f32x4* p = (const f32x4*)(SSQP + (size_t)r * 64); float s = 0.f;
#pragma unroll
              for (int j = 0; j < 16; ++j) { const f32x4 v = p[j]; s += (v.x + v.y) + (v.z + v.w); }
              RSTD[r] = 1.0f / sqrtf(s * (1.f / D) + EPS); } } }
            LOCAL_BAR();
        } else { GRID_BAR(); }
    }
    {
        PHASE_IDS();
        const bool poison = (__hip_atomic_load(ctl + CW_BAR + XB_TMO, RLX_AGENT) != 0u);
        const int gw = vcu * NWAVES + wave, NGW = G * NWAVES;
        for (int m = gw; m < M; m += NGW) {
            const GAS v4u* xr = (const GAS v4u*)(XN + (size_t)m * D) + lane; GAS f32x4* orow = (GAS f32x4*)(out + (size_t)m * D);
            v4u q[8]; float s = 0.f;
#pragma unroll
            for (int j = 0; j < 8; ++j) { q[j] = xr[64 * j]; const float a0 = bflo(q[j].x), a1 = bfhi(q[j].x), a2 = bflo(q[j].y), a3 = bfhi(q[j].y), a4 = bflo(q[j].z), a5 = bfhi(q[j].z), a6 = bflo(q[j].w), a7 = bfhi(q[j].w);
                s += ((a0 * a0 + a1 * a1) + (a2 * a2 + a3 * a3)) + ((a4 * a4 + a5 * a5) + (a6 * a6 + a7 * a7)); }
            float rstd = 1.0f / sqrtf(wave_sum(s) * (1.f / D) + EPS); if (poison) rstd = __builtin_nanf("");
#pragma unroll
            for (int j = 0; j < 8; ++j) { const int c = (64 * j + lane) * 8; const f32x4 g0 = *(const GAS f32x4*)(final_norm + c), g1 = *(const GAS f32x4*)(final_norm + c + 4);
                orow[(c >> 2)] = (f32x4){bflo(q[j].x) * rstd * g0.x, bfhi(q[j].x) * rstd * g0.y, bflo(q[j].y) * rstd * g0.z, bfhi(q[j].y) * rstd * g0.w};
                orow[(c >> 2) + 1] = (f32x4){bflo(q[j].z) * rstd * g1.x, bfhi(q[j].z) * rstd * g1.y, bflo(q[j].w) * rstd * g1.z, bfhi(q[j].w) * rstd * g1.w}; }
        }
    }
}

extern "C" void kernel_launch(void* const* d_in, const int* in_sizes, int n_in, void* d_out, int out_size, void* d_ws, size_t ws_size, hipStream_t stream) {
    static int grid = 0;
    if (grid == 0) {
        if (n_in != 17 || in_sizes[0] != M * D || out_size != M * D || ws_size < WS_END) { fprintf(stderr, "kernel_launch: unexpected shapes (n_in %d, in0 %d, out %d, ws %zu; need ws >= %zu); nothing launched\n", n_in, n_in > 0 ? in_sizes[0] : -1, out_size, ws_size, (size_t)WS_END); grid = -1; return; }
        int dev = 0, cus = 0, per_cu = 0;
        if (hipGetDevice(&dev) != hipSuccess || hipDeviceGetAttribute(&cus, hipDeviceAttributeMultiprocessorCount, dev) != hipSuccess) { fprintf(stderr, "kernel_launch: device query failed\n"); grid = -1; return; }
        if (hipFuncSetAttribute((const void*)fwd_kernel, hipFuncAttributeMaxDynamicSharedMemorySize, LDS_BYTES) != hipSuccess) { fprintf(stderr, "kernel_launch: hipFuncSetAttribute failed\n"); grid = -1; return; }
        if (hipOccupancyMaxActiveBlocksPerMultiprocessor(&per_cu, (const void*)fwd_kernel, NWAVES * 64, LDS_BYTES) != hipSuccess || per_cu < 1)
            fprintf(stderr, "kernel_launch: note: occupancy query reports %d workgroups per CU\n", per_cu);
        (void)hipGetLastError();
        grid = cus;
    }
    if (grid < 0) return;
    if (hipMemsetAsync((char*)d_ws + WS_CTL, 0, CTL_ZERO_BYTES, stream) != hipSuccess) { fprintf(stderr, "kernel_launch: memset failed\n"); return; }
    Args a{};
    for (int i = 0; i < 17; ++i) a.in[i] = d_in[i];
    a.out = (float*)d_out; a.ws = (unsigned char*)d_ws;
    hipLaunchKernelGGL(fwd_kernel, dim3(grid), dim3(NWAVES * 64), LDS_BYTES, stream, a);
    const hipError_t le = hipPeekAtLastError();
    if (le != hipSuccess) fprintf(stderr, "kernel_launch: launch failed: %s\n", hipGetErrorName(le));
}
```
